# Optimizing an MI355X kernel written in HIP

```python
import jax, jax.numpy as jnp
from jax import lax
import numpy as np

D_MODEL = 1024
BATCH = 2
SEQ = 8192
DEPTH = 2

PLE_DIM = 256
RET_HEADS = 6
RET_HEAD_DIM = 64
RET_WIDTH = RET_HEADS * RET_HEAD_DIM
POOL_WINDOWS = (2, 4, 8, 16)
POOL_GROUPS = len(POOL_WINDOWS)
POOL_GROUP_DIM = 64
POOL_WIDTH = POOL_GROUPS * POOL_GROUP_DIM
MLSTM_HEADS = 4
MLSTM_HEAD_DIM = 96
MLSTM_WIDTH = MLSTM_HEADS * MLSTM_HEAD_DIM
MLSTM_CONV = 4
MIX_WIDTH = RET_WIDTH + POOL_WIDTH + MLSTM_WIDTH
IN_WIDTH = 4 * RET_WIDTH + POOL_WIDTH + 4 * MLSTM_WIDTH + 2 * MLSTM_HEADS
CHUNK = 128
D_FF = -(-8 * D_MODEL // (3 * 256)) * 256
ROPE_BASE = 10000.0
EPS = 1e-6

kernel_name = "hybrid_retention_pool_mlstm_block"


def rmsnorm(x, g):
    xf = x.astype(jnp.float32)
    y = xf * lax.rsqrt(jnp.mean(xf * xf, axis=-1, keepdims=True) + EPS)
    return (y * g.astype(jnp.float32)).astype(x.dtype)


def head_norm(h, g):
    b, s, nh, d = h.shape
    mu = jnp.mean(h, axis=-1, keepdims=True)
    hc = h - mu
    var = jnp.mean(hc * hc, axis=-1, keepdims=True)
    y = (hc * lax.rsqrt(var + EPS)).reshape(b, s, nh * d)
    return y * g.astype(jnp.float32)


def rope(x, pos):
    half = x.shape[-1] // 2
    inv = ROPE_BASE ** (-jnp.arange(half, dtype=jnp.float32) / half)
    ang = pos.astype(jnp.float32)[..., None] * inv
    cos = jnp.cos(ang)[:, :, None, :]
    sin = jnp.sin(ang)[:, :, None, :]
    x1, x2 = x[..., :half], x[..., half:]
    return jnp.concatenate([x1 * cos - x2 * sin, x1 * sin + x2 * cos], axis=-1)


def to_chunks(x):
    b, s, nh, d = x.shape
    return x.reshape(b, s // CHUNK, CHUNK, nh, d).transpose(0, 3, 1, 2, 4)


def from_chunks(y):
    b, nh, nc, c, d = y.shape
    return y.transpose(0, 2, 3, 1, 4).reshape(b, nc * c, nh, d)


def causal_conv(x, w, bias):
    k, c = w.shape
    y = lax.conv_general_dilated(
        x, w[:, None, :].astype(x.dtype), window_strides=(1,),
        padding=((k - 1, 0),), dimension_numbers=("NWC", "WIO", "NWC"),
        feature_group_count=c)
    return y + bias.astype(x.dtype)


def retention(q, k, v, g, pos, gn_gain):
    f32 = jnp.float32
    b, s, _ = q.shape
    nh, d = RET_HEADS, RET_HEAD_DIM
    qh = rope(q.reshape(b, s, nh, d).astype(f32), pos)
    kh = rope(k.reshape(b, s, nh, d).astype(f32), pos) * (d ** -0.5)
    vh = v.reshape(b, s, nh, d).astype(f32)
    log_gamma = jnp.log1p(-(2.0 ** (-5.0 - jnp.arange(nh, dtype=f32))))
    qc, kc, vc = to_chunks(qh), to_chunks(kh), to_chunks(vh)
    idx = jnp.arange(CHUNK, dtype=f32)
    rel = idx[:, None] - idx[None, :]
    decay = jnp.where(rel >= 0, jnp.exp(log_gamma[:, None, None] * jnp.maximum(rel, 0.0)), 0.0)
    scores = jnp.einsum('bhncd,bhnsd->bhncs', qc, kc) * decay[None, :, None]
    y_intra = jnp.einsum('bhncs,bhnse->bhnce', scores, vc)
    zeta = jnp.exp(log_gamma[:, None] * (CHUNK - 1 - idx))
    kv = jnp.einsum('bhncd,bhnce->bhnde', kc * zeta[None, :, None, :, None], vc)
    chunk_decay = jnp.exp(log_gamma * CHUNK)[None, :, None, None]

    def step(r, kv_n):
        return chunk_decay * r + kv_n, r

    _, r_prev = lax.scan(step, jnp.zeros((b, nh, d, d), f32), jnp.moveaxis(kv, 2, 0))
    r_prev = jnp.moveaxis(r_prev, 0, 2)
    xi = jnp.exp(log_gamma[:, None] * (idx + 1.0))
    y_cross = jnp.einsum('bhncd,bhnde->bhnce', qc, r_prev) * xi[None, :, None, :, None]
    y = head_norm(from_chunks(y_intra + y_cross), gn_gain)
    return (jax.nn.silu(g.astype(f32)) * y).astype(q.dtype)


def pool_mix(u, w_pool, pool_scale):
    f32 = jnp.float32
    b, s, _ = u.shape
    uf = u.astype(f32)
    csum = jnp.pad(lax.cumsum(uf, axis=1), ((0, 0), (1, 0), (0, 0)))
    t1 = jnp.arange(1, s + 1, dtype=f32)
    outs = []
    for gi, w in enumerate(POOL_WINDOWS):
        lo, hi = gi * POOL_GROUP_DIM, (gi + 1) * POOL_GROUP_DIM
        cs = csum[:, :, lo:hi]
        upper = cs[:, 1:]
        lower = jnp.pad(cs[:, :s + 1 - w], ((0, 0), (w - 1, 0), (0, 0)))
        count = jnp.minimum(t1, float(w))[None, :, None]
        outs.append((upper - lower) / count - uf[:, :, lo:hi])
    pooled = jnp.stack(outs, axis=2)
    mixed = jnp.einsum('bsgc,gcd->bsgd', pooled, w_pool.astype(f32)).reshape(b, s, POOL_WIDTH)
    return (mixed * pool_scale.astype(f32)).astype(u.dtype)


def mlstm(q, k, v, o, i_pre, f_pre, conv_w, conv_b, b_i, b_f, gn_gain):
    f32 = jnp.float32
    b, s, _ = q.shape
    nh, d = MLSTM_HEADS, MLSTM_HEAD_DIM
    qk = jax.nn.silu(causal_conv(jnp.concatenate([q, k], axis=-1).astype(f32), conv_w.astype(f32), conv_b))
    qh = qk[..., :MLSTM_WIDTH].reshape(b, s, nh, d) * (d ** -0.5)
    kh = qk[..., MLSTM_WIDTH:].reshape(b, s, nh, d)
    vh = v.reshape(b, s, nh, d).astype(f32)
    log_i = i_pre.astype(f32) + b_i.astype(f32)
    log_f = jax.nn.log_sigmoid(f_pre.astype(f32) + b_f.astype(f32))
    nc = s // CHUNK
    qc, kc, vc = to_chunks(qh), to_chunks(kh), to_chunks(vh)
    li = log_i.reshape(b, nc, CHUNK, nh).transpose(0, 3, 1, 2)
    lf = log_f.reshape(b, nc, CHUNK, nh).transpose(0, 3, 1, 2)
    bcum = lax.cumsum(lf, axis=3)
    b_last = bcum[..., -1]
    causal = jnp.tril(jnp.ones((CHUNK, CHUNK), dtype=bool))
    log_d = jnp.where(causal, bcum[..., :, None] - bcum[..., None, :] + li[..., None, :], -jnp.inf)
    log_w = b_last[..., None] - bcum + li
    a = jnp.max(log_w, axis=-1)
    kw = kc * jnp.exp(log_w - a[..., None])[..., None]
    kv_loc = jnp.einsum('bhncd,bhnce->bhnde', kw, vc)
    n_loc = jnp.sum(kw, axis=3)

    def step(carry, xs):
        c_st, n_st, m_st = carry
        kv_n, n_n, a_n, bl_n = xs
        m_new = jnp.maximum(bl_n + m_st, a_n)
        s_old = jnp.exp(bl_n + m_st - m_new)
        s_new = jnp.exp(a_n - m_new)
        c_new = s_old[..., None, None] * c_st + s_new[..., None, None] * kv_n
        n_new = s_old[..., None] * n_st + s_new[..., None] * n_n
        return (c_new, n_new, m_new), (c_st, n_st, m_st)

    init = (jnp.zeros((b, nh, d, d), f32), jnp.zeros((b, nh, d), f32), jnp.zeros((b, nh), f32))
    xs = (jnp.moveaxis(kv_loc, 2, 0), jnp.moveaxis(n_loc, 2, 0), jnp.moveaxis(a, 2, 0), jnp.moveaxis(b_last, 2, 0))
    _, (c_prev, n_prev, m_prev) = lax.scan(step, init, xs)
    c_prev = jnp.moveaxis(c_prev, 0, 2)
    n_prev = jnp.moveaxis(n_prev, 0, 2)
    m_prev = jnp.moveaxis(m_prev, 0, 2)
    log_inter = bcum + m_prev[..., None]
    m_row = jnp.maximum(log_inter, jnp.max(log_d, axis=-1))
    sc = jnp.einsum('bhncd,bhnsd->bhncs', qc, kc) * jnp.exp(log_d - m_row[..., None])
    inter = jnp.exp(log_inter - m_row)
    num = jnp.einsum('bhncs,bhnse->bhnce', sc, vc) + inter[..., None] * jnp.einsum('bhncd,bhnde->bhnce', qc, c_prev)
    den = jnp.sum(sc, axis=-1) + inter * jnp.einsum('bhncd,bhnd->bhnc', qc, n_prev)
    den = jnp.maximum(jnp.abs(den), jnp.exp(-m_row))
    h = head_norm(from_chunks(num / den[..., None]), gn_gain)
    return (jax.nn.sigmoid(o.astype(f32)) * h).astype(q.dtype)


def hybrid_layer(x, p_i, positions, norm_mix, w_in, ret_gn, pool_w, pool_scale,
                 conv_w, conv_b, b_igate, b_fgate, mlstm_gn, w_out, norm_ffn,
                 w_gate_up, w_down, norm_ple, w_ple_gate, w_ple_proj):
    h = rmsnorm(x, norm_mix)
    z = h @ w_in
    sizes = [RET_WIDTH] * 4 + [POOL_WIDTH] + [MLSTM_WIDTH] * 4 + [MLSTM_HEADS] * 2
    offs = np.cumsum(sizes)[:-1].tolist()
    (rq, rk, rv, rg, pu, mq, mk, mv, mo, mi, mf) = jnp.split(z, offs, axis=-1)
    y_ret = retention(rq, rk, rv, rg, positions, ret_gn)
    y_pool = pool_mix(pu, pool_w, pool_scale)
    y_ml = mlstm(mq, mk, mv, mo, mi, mf, conv_w, conv_b, b_igate, b_fgate, mlstm_gn)
    x = x + jnp.concatenate([y_ret, y_pool, y_ml], axis=-1) @ w_out
    h = rmsnorm(x, norm_ffn)
    gu = h @ w_gate_up
    x = x + (jax.nn.silu(gu[..., :D_FF]) * gu[..., D_FF:]) @ w_down
    hp = rmsnorm(x, norm_ple)
    x = x + jax.nn.sigmoid(hp @ w_ple_gate) * (p_i @ w_ple_proj)
    return x


def setup_inputs(seed: int = 0) -> dict:
    key = jax.random.key(seed)
    ks = jax.random.split(key, 24)
    f32 = jnp.float32

    def nrm(k, shape, scale):
        return jax.random.normal(k, shape, f32) * scale

    def gain(k, shape):
        return 1.0 + 0.05 * jax.random.normal(k, shape, f32)

    return {
        "x": nrm(ks[0], (BATCH, SEQ, D_MODEL), 1.0),
        "p": nrm(ks[1], (DEPTH, BATCH, SEQ, PLE_DIM), 1.0),
        "positions": jnp.broadcast_to(jnp.arange(SEQ, dtype=jnp.int32), (BATCH, SEQ)),
        "norm_mix": gain(ks[2], (DEPTH, D_MODEL)),
        "w_in": nrm(ks[3], (DEPTH, D_MODEL, IN_WIDTH), D_MODEL ** -0.5),
        "ret_gn": gain(ks[4], (DEPTH, RET_WIDTH)),
        "pool_w": nrm(ks[5], (DEPTH, POOL_GROUPS, POOL_GROUP_DIM, POOL_GROUP_DIM), POOL_GROUP_DIM ** -0.5),
        "pool_scale": gain(ks[6], (DEPTH, POOL_WIDTH)),
        "conv_w": nrm(ks[7], (DEPTH, MLSTM_CONV, 2 * MLSTM_WIDTH), MLSTM_CONV ** -0.5),
        "conv_b": nrm(ks[8], (DEPTH, 2 * MLSTM_WIDTH), 0.02),
        "b_igate": nrm(ks[9], (DEPTH, MLSTM_HEADS), 0.1),
        "b_fgate": jnp.broadcast_to(jnp.linspace(3.0, 6.0, MLSTM_HEADS, dtype=f32), (DEPTH, MLSTM_HEADS)) + nrm(ks[10], (DEPTH, MLSTM_HEADS), 0.1),
        "mlstm_gn": gain(ks[11], (DEPTH, MLSTM_WIDTH)),
        "w_out": nrm(ks[12], (DEPTH, MIX_WIDTH, D_MODEL), MIX_WIDTH ** -0.5),
        "norm_ffn": gain(ks[13], (DEPTH, D_MODEL)),
        "w_gate_up": nrm(ks[14], (DEPTH, D_MODEL, 2 * D_FF), D_MODEL ** -0.5),
        "w_down": nrm(ks[15], (DEPTH, D_FF, D_MODEL), D_FF ** -0.5),
        "norm_ple": gain(ks[16], (DEPTH, D_MODEL)),
        "w_ple_gate": nrm(ks[17], (DEPTH, D_MODEL, D_MODEL), D_MODEL ** -0.5),
        "w_ple_proj": nrm(ks[18], (DEPTH, PLE_DIM, D_MODEL), PLE_DIM ** -0.5),
        "norm_final": gain(ks[19], (D_MODEL,)),
    }


def reference(x, p, positions, norm_mix, w_in, ret_gn, pool_w, pool_scale,
              conv_w, conv_b, b_igate, b_fgate, mlstm_gn, w_out, norm_ffn,
              w_gate_up, w_down, norm_ple, w_ple_gate, w_ple_proj, norm_final):
    for i in range(DEPTH):
        x = hybrid_layer(x, p[i], positions, norm_mix[i], w_in[i], ret_gn[i],
                         pool_w[i], pool_scale[i], conv_w[i], conv_b[i],
                         b_igate[i], b_fgate[i], mlstm_gn[i], w_out[i],
                         norm_ffn[i], w_gate_up[i], w_down[i], norm_ple[i],
                         w_ple_gate[i], w_ple_proj[i])
    return rmsnorm(x, norm_final)
```

```cpp
#ifndef N_LAUNCHES
#define N_LAUNCHES 1
#endif
#include <hip/hip_runtime.h>
#include <hip/hip_cooperative_groups.h>
#include <cstdio>
#include <cstdint>
namespace cg = cooperative_groups;

#define LAS __attribute__((address_space(3)))
typedef unsigned short bf16_t;
typedef short bf16x8 __attribute__((ext_vector_type(8)));
typedef float f32x4 __attribute__((ext_vector_type(4)));
typedef unsigned u32x4 __attribute__((ext_vector_type(4)));
typedef unsigned u32x2 __attribute__((ext_vector_type(2)));

constexpr int T = 16384, DM = 1024, SEQ = 8192, DEPTH = 2, DFF = 2816, INW = 3336, PLE = 256;
constexpr int ZS = 3584;
constexpr int ZQ = 0, ZK = 384, ZV = 768, ZG = 1152, ZYP = 1536, ZMO = 1792, ZMQ = 2176, ZMK = 2560, ZMV = 2944, ZPU = 3328;
constexpr int LDS_BYTES = 147456;
constexpr size_t WL = 29392896;
constexpr size_t O_WIN = 0, O_WOUT = 7340032, O_WGU = 9437184, O_WD = 20971520, O_WPG = 26738688, O_WPP = 28835840, O_WPT = 29360128;
constexpr size_t WS_XB0 = 58785792, WS_Z = 92340224, WS_PB = 209780736, WS_ST = 226557952, WS_GATES = 260112384, WS_SSQ0 = 260636672, WS_SSQ1 = 261685248, WS_SC = 262733824, WS_Z0 = 262739968, WS_BAR = 262752256, WS_END = 262768640;
constexpr size_t ST_ML_OFF = 12582912;
constexpr int ML_ST = 9312;

__device__ const float INV_FREQ[32] = {
    1.000000000e+00f, 7.498942614e-01f, 5.623413324e-01f, 4.216965139e-01f, 3.162277639e-01f, 2.371373773e-01f, 1.778279394e-01f, 1.333521307e-01f,
    1.000000015e-01f, 7.498941571e-02f, 5.623413250e-02f, 4.216965288e-02f, 3.162277490e-02f, 2.371373773e-02f, 1.778279431e-02f, 1.333521493e-02f,
    9.999999776e-03f, 7.498941850e-03f, 5.623413250e-03f, 4.216964822e-03f, 3.162277630e-03f, 2.371373586e-03f, 1.778279431e-03f, 1.333521446e-03f,
    1.000000047e-03f, 7.498942432e-04f, 5.623413017e-04f, 4.216965172e-04f, 3.162277571e-04f, 2.371373703e-04f, 1.778279402e-04f, 1.333521504e-04f};

__device__ __forceinline__ float l2gamma(int h) {
    return h == 0 ? -0.04580368961312479f : h == 1 ? -0.02272007650008353f : h == 2 ? -0.011315313227834146f : h == 3 ? -0.005646563141142063f : h == 4 ? -0.0028205190623786626f : -0.0014095702546713536f;
}
typedef float f32x2v_ __attribute__((ext_vector_type(2)));
typedef __bf16 bf16x2v_ __attribute__((ext_vector_type(2)));
__device__ __forceinline__ unsigned cvt_pk_bf16(float lo, float hi) { const f32x2v_ v = {lo, hi}; const bf16x2v_ r = __builtin_convertvector(v, bf16x2v_); return __builtin_bit_cast(unsigned, r); }
__device__ __forceinline__ float bflo(unsigned w) { return __uint_as_float(w << 16); }
__device__ __forceinline__ float bfhi(unsigned w) { return __uint_as_float(w & 0xffff0000u); }
__device__ __forceinline__ float fsigmoid(float x) { return __builtin_amdgcn_rcpf(1.f + __expf(-x)); }
__device__ __forceinline__ float wave_sum(float v) {
#pragma unroll
    for (int o = 1; o < 64; o <<= 1) v += __shfl_xor(v, o);
    return v;
}
__device__ __forceinline__ float wave_max(float v) {
#pragma unroll
    for (int o = 1; o < 64; o <<= 1) v = fmaxf(v, __shfl_xor(v, o));
    return v;
}
__device__ __forceinline__ float wave_scan_sum(float v, int lane) {
#pragma unroll
    for (int o = 1; o < 64; o <<= 1) { const float t = __shfl_up(v, o); if (lane >= o) v += t; }
    return v;
}
__device__ __forceinline__ float wave_scan_max(float v, int lane) {
#pragma unroll
    for (int o = 1; o < 64; o <<= 1) { const float t = __shfl_up(v, o); if (lane >= o) v = fmaxf(v, t); }
    return v;
}

namespace pg8 {
__device__ __forceinline__ float row_rs_g(const float* ssq, int row) { const f32x4* p = (const f32x4*)(ssq + (size_t)row * 16); const f32x4 s = (p[0] + p[1]) + (p[2] + p[3]); return rsqrtf(((s.x + s.y) + (s.z + s.w)) * (1.f / 1024.f) + 1e-6f); }
constexpr int BM = 256, BK = 64, HALF = 128, HTB = HALF * BK * 2, STAGE_BYTES = 8 * HTB, NXCD = 8, WGM = 8;
__host__ __device__ __forceinline__ int lds_byte(int r, int c) { const int st = (r >> 4) * 2 + (c >> 5), rr = r & 15, cc = c & 31, ob = rr * 64 + cc * 2; return st * 1024 + (ob ^ (((ob >> 9) & 1) << 5)); }
__host__ __device__ __forceinline__ void stage_rc(int b, int& R, int& C) { const int st = b / 1024, sb = b % 1024, swz = sb ^ (((sb >> 9) & 1) << 5); R = (st >> 1) * 16 + swz / 64; C = (st & 1) * 32 + (swz % 64) / 2; }
__host__ __device__ __forceinline__ int perm32(int rho) { const int n = rho >> 4, i = rho & 15; return 8 * (i >> 2) + 4 * n + (i & 3); }

struct Unit { int pm, pn; };
struct Gemm { const bf16_t* A; const bf16_t* Bt; int M, N, K, lda; const float* ssq; };

struct StaticOrder {
    int nM, nN, nwg, G, c;
    __device__ void init(int M, int N, int G_, int c_) { nM = M / BM; nN = N / BM; nwg = nM * nN; G = G_; c = c_; }
    __device__ bool next(int i, Unit& u) const {
        const long L = (long)i * G + c; if (L >= nwg) return false;
        int wgid = (int)L; { const int q = nwg / NXCD, r = nwg % NXCD, xcd = wgid % NXCD, off = wgid / NXCD; wgid = (xcd < r ? xcd * (q + 1) : r * (q + 1) + (xcd - r) * q) + off; }
        const int nig = WGM * nN, gid = wgid / nig, fm = gid * WGM, gsz = (nM - fm) < WGM ? (nM - fm) : WGM;
        u.pm = fm + ((wgid % nig) % gsz); u.pn = (wgid % nig) / gsz; return true;
    }
};

template <class Epi, bool ALIGN_EPI>
__device__ __forceinline__ void gemm_phase(LAS unsigned char* lds, const Gemm g, const StaticOrder& S, const Epi& E) {
    int tid = threadIdx.x; asm volatile("" : "+v"(tid));
    const int wid = __builtin_amdgcn_readfirstlane(tid >> 6), lane = tid & 63, wr = wid >> 2, wc = wid & 3, fr = lane & 15, fq = lane >> 4;
    int K = g.K; asm volatile("" : "+s"(K));
    const int nt = K / BK, lda = g.lda;
    unsigned voffA[2], voffB[2];
#pragma unroll
    for (int i = 0; i < 2; ++i) { int R, C; stage_rc(tid * 16 + i * 8192, R, C); const int Rb = (R & ~31) + perm32(R & 31);
        voffA[i] = (unsigned)(R * lda + C) * 2u; voffB[i] = (unsigned)(Rb * K + C) * 2u; }
    const size_t kstep = (size_t)(BK * 2);
    const size_t hstepA = (size_t)HALF * lda * 2, tstepA = 2 * hstepA;
    const size_t hstepB = (size_t)HALF * K * 2, tstepB = 2 * hstepB;
    const unsigned ldsw = (unsigned)wid * 1024u;
    const int aoff = lds_byte(wr * 64 + fr, fq * 8), boff = lds_byte(wc * 32 + fr, fq * 8);
#define PG8_SA(b, h) (((b) * 2 + (h)) * HTB)
#define PG8_SB(b, h) ((4 + (b) * 2 + (h)) * HTB)
#define PG8_STAGE(bufoff, gbase, voff) do { _Pragma("unroll") for (int _i = 0; _i < 2; ++_i) \
        __builtin_amdgcn_global_load_lds((const unsigned*)((const char*)(gbase) + (voff)[_i]), (LAS unsigned*)(lds + (bufoff) + ldsw + _i * 8192), 16, 0, 0); } while (0)
#define PG8_LDA(dst, b, h) do { _Pragma("unroll") for (int m = 0; m < 4; ++m) _Pragma("unroll") for (int k = 0; k < 2; ++k) dst[m][k] = *(const LAS bf16x8*)(lds + PG8_SA(b, h) + aoff + m * 2048 + k * 1024); } while (0)
#define PG8_LDB(dst, b, h) do { _Pragma("unroll") for (int n = 0; n < 2; ++n) _Pragma("unroll") for (int k = 0; k < 2; ++k) dst[n][k] = *(const LAS bf16x8*)(lds + PG8_SB(b, h) + boff + n * 2048 + k * 1024); } while (0)
#define PG8_MMA(ai, bj, At, Bt) do { __builtin_amdgcn_s_setprio(1); _Pragma("unroll") for (int m = 0; m < 4; ++m) _Pragma("unroll") for (int n = 0; n < 2; ++n) _Pragma("unroll") for (int k = 0; k < 2; ++k) \
        acc[ai][bj][m][n] = __builtin_amdgcn_mfma_f32_16x16x32_bf16(Bt[n][k], At[m][k], acc[ai][bj][m][n], 0, 0, 0); __builtin_amdgcn_s_setprio(0); } while (0)
#define PG8_WAIT_V(n) asm volatile("s_waitcnt vmcnt(" #n ")" ::: "memory")
#define PG8_WAIT_L(n) asm volatile("s_waitcnt lgkmcnt(" #n ")" ::: "memory")
#define PG8_BAR __builtin_amdgcn_s_barrier()
#define PG8_SCHED __builtin_amdgcn_sched_barrier(0)
    Unit cur, nxt; int ui = 0;
    if (!S.next(0, cur)) return;
    LAS float* rsbuf = (LAS float*)(lds + STAGE_BYTES); int rs_pm = -1;
    if (g.ssq) { rs_pm = cur.pm; if (tid < 256) rsbuf[tid] = row_rs_g(g.ssq, cur.pm * 256 + tid); __syncthreads(); }
    f32x4 acc[2][2][4][2];
#pragma unroll
    for (int a = 0; a < 2; ++a)
#pragma unroll
        for (int b = 0; b < 2; ++b)
#pragma unroll
            for (int m = 0; m < 4; ++m)
#pragma unroll
                for (int n = 0; n < 2; ++n) acc[a][b][m][n] = (f32x4){0.f, 0.f, 0.f, 0.f};
    bf16x8 At[4][2], B0[2][2], B1[2][2];
    const char* cA = (const char*)g.A + (size_t)cur.pm * tstepA; const char* cB = (const char*)g.Bt + (size_t)cur.pn * tstepB;
    PG8_STAGE(PG8_SB(0, 0), cB, voffB); PG8_STAGE(PG8_SB(0, 1), cB + hstepB, voffB); PG8_STAGE(PG8_SA(0, 0), cA, voffA); PG8_STAGE(PG8_SA(0, 1), cA + hstepA, voffA);
    if (wr == 1) PG8_BAR;
    PG8_WAIT_V(2); PG8_BAR;
    PG8_STAGE(PG8_SB(1, 0), cB + kstep, voffB); PG8_STAGE(PG8_SA(1, 0), cA + kstep, voffA); PG8_STAGE(PG8_SB(1, 1), cB + hstepB + kstep, voffB);
    PG8_WAIT_V(6); PG8_BAR;
    for (;;) {
        const bool has_next = S.next(ui + 1, nxt);
        const char* nA = has_next ? (const char*)g.A + (size_t)nxt.pm * tstepA : cA; const char* nB = has_next ? (const char*)g.Bt + (size_t)nxt.pn * tstepB : cB;
        for (int t = 0; t < nt; t += 2) {
            const bool last = (t == nt - 2);
            const char* a1 = cA + (size_t)(t + 1) * kstep;
            const char* a2 = last ? nA : cA + (size_t)(t + 2) * kstep; const char* b2 = last ? nB : cB + (size_t)(t + 2) * kstep;
            const char* a3 = a2 + kstep; const char* b3 = b2 + kstep;
            PG8_LDB(B0, 0, 0); PG8_LDB(B1, 0, 1); PG8_SCHED; PG8_LDA(At, 0, 0); PG8_STAGE(PG8_SA(1, 1), a1 + hstepA, voffA);
            PG8_WAIT_V(8); PG8_WAIT_L(0); PG8_BAR; PG8_MMA(0, 0, At, B0); PG8_MMA(0, 1, At, B1); PG8_BAR; PG8_SCHED;
            PG8_LDA(At, 0, 1); PG8_STAGE(PG8_SB(0, 0), b2, voffB); PG8_STAGE(PG8_SB(0, 1), b2 + hstepB, voffB); PG8_STAGE(PG8_SA(0, 0), a2, voffA);
            PG8_WAIT_V(8); PG8_WAIT_L(0); PG8_BAR; PG8_MMA(1, 0, At, B0); PG8_MMA(1, 1, At, B1); PG8_BAR; PG8_SCHED;
            PG8_LDB(B0, 1, 0); PG8_LDB(B1, 1, 1); PG8_SCHED; PG8_LDA(At, 1, 0); PG8_STAGE(PG8_SA(0, 1), a2 + hstepA, voffA);
            PG8_WAIT_V(8); PG8_WAIT_L(0); PG8_BAR; PG8_MMA(0, 0, At, B0); PG8_MMA(0, 1, At, B1); PG8_BAR; PG8_SCHED;
            PG8_LDA(At, 1, 1); PG8_STAGE(PG8_SB(1, 0), b3, voffB); PG8_STAGE(PG8_SB(1, 1), b3 + hstepB, voffB); PG8_STAGE(PG8_SA(1, 0), a3, voffA);
            PG8_WAIT_V(8); PG8_WAIT_L(0); PG8_BAR; PG8_MMA(1, 0, At, B0); PG8_MMA(1, 1, At, B1); PG8_BAR; PG8_SCHED;
        }
        if constexpr (ALIGN_EPI) { if (wr == 0) PG8_BAR; }
        E(acc, cur, wr, wc, fr, fq, rsbuf, rs_pm);
        if (!has_next) break;
#pragma unroll
        for (int a = 0; a < 2; ++a)
#pragma unroll
            for (int b = 0; b < 2; ++b)
#pragma unroll
                for (int m = 0; m < 4; ++m)
#pragma unroll
                    for (int n = 0; n < 2; ++n) acc[a][b][m][n] = (f32x4){0.f, 0.f, 0.f, 0.f};
        cur = nxt; cA = nA; cB = nB; ++ui;
        if constexpr (ALIGN_EPI) { if (wr == 1) PG8_BAR; }
    }
    PG8_WAIT_V(0);
    if constexpr (!ALIGN_EPI) { if (wr == 0) PG8_BAR; }
    PG8_BAR;
#undef PG8_SA
#undef PG8_SB
#undef PG8_STAGE
#undef PG8_LDA
#undef PG8_LDB
#undef PG8_MMA
#undef PG8_WAIT_V
#undef PG8_WAIT_L
#undef PG8_BAR
#undef PG8_SCHED
}
}

#define XB_TMO      128
#define XB_XCNT(j)  (256  + 64 * (j))
#define XB_XSUB(j)  (1280 + 64 * (j))
#define XB_XGEN(j)  (2304 + 64 * (j))
#define XB_TOP      3328
#define XB_TOPGEN   3392
#define XCD_BAR_WORDS 3456
#define XB_SPIN_CAP (1u << 18)

__device__ __forceinline__ unsigned xb_ld(unsigned* p)              { return __hip_atomic_load(p, __ATOMIC_RELAXED, __HIP_MEMORY_SCOPE_AGENT); }
__device__ __forceinline__ unsigned xb_add(unsigned* p, unsigned v) { return __hip_atomic_fetch_add(p, v, __ATOMIC_RELAXED, __HIP_MEMORY_SCOPE_AGENT); }
__device__ __forceinline__ unsigned xb_xcc_id() { return (unsigned)__builtin_amdgcn_s_getreg((3 << 11) | 20) & 0xFu; }
#define XB_SPIN(cond, bar) do { unsigned _sp = 0; while (cond) { __builtin_amdgcn_s_sleep(1); \
    if ((++_sp & 255u) == 0u) { if (xb_ld(&(bar)[XB_TMO])) break; if (_sp > XB_SPIN_CAP) { atomicAdd(&(bar)[XB_TMO], 1u); break; } } } } while (0)

struct XcdBarrier {
    unsigned* bar; unsigned x;
    volatile LAS unsigned* st;
};

__device__ __forceinline__ XcdBarrier xcd_barrier_post(unsigned* bar, volatile LAS unsigned* st) {
    XcdBarrier b; b.bar = bar; b.x = xb_xcc_id(); b.st = st;
    if (threadIdx.x == 0) (void)xb_add(&bar[XB_XCNT(b.x)], 1u);
    return b;
}
__device__ __forceinline__ void xcd_barrier_complete(unsigned* bar, unsigned x, unsigned& nloc, unsigned& nx) {
    const unsigned G = gridDim.x * gridDim.y * gridDim.z;
    unsigned sum, cnt, mine, sp = 0u;
    for (;;) {
        sum = 0u; cnt = 0u; mine = 0u;
#pragma unroll
        for (unsigned j = 0; j < 16; ++j) { const unsigned c = xb_ld(&bar[XB_XCNT(j)]); sum += c; cnt += (c > 0u) ? 1u : 0u; mine = (j == x) ? c : mine; }
        if (sum == G) break;
        __builtin_amdgcn_s_sleep(1);
        if ((++sp & 255u) == 0u) { if (xb_ld(&bar[XB_TMO])) break; if (sp > XB_SPIN_CAP) { atomicAdd(&bar[XB_TMO], 1u); break; } }
    }
    nloc = mine > 0u ? mine : 1u; nx = cnt > 0u ? cnt : 1u;
}

__device__ __forceinline__ void xcd_barrier(const XcdBarrier& b) {
    asm volatile("s_waitcnt vmcnt(0)" ::: "memory");
    __syncthreads();
    if (threadIdx.x == 0) {
        unsigned* bar = b.bar;
        __builtin_amdgcn_s_waitcnt(0);
        unsigned nloc = b.st[0], nx = b.st[1];
        if (nloc == 0u) { xcd_barrier_complete(bar, b.x, nloc, nx); b.st[0] = nloc; b.st[1] = nx; }
        const unsigned old = xb_add(&bar[XB_XSUB(b.x)], 1u);
        const unsigned gen = old / nloc;
        if (old + 1u == (gen + 1u) * nloc) {
            __builtin_amdgcn_fence(__ATOMIC_RELEASE, "agent");
            asm volatile("s_waitcnt vmcnt(0)" ::: "memory");
            const unsigned og = xb_add(&bar[XB_TOP], 1u);
            const unsigned tg = og / nx;
            if (og + 1u == (tg + 1u) * nx) xb_add(&bar[XB_TOPGEN], 1u);
            else XB_SPIN(xb_ld(&bar[XB_TOPGEN]) == tg, bar);
            __builtin_amdgcn_fence(__ATOMIC_ACQUIRE, "agent");
            xb_add(&bar[XB_XGEN(b.x)], 1u);
            asm volatile("s_waitcnt vmcnt(0)" ::: "memory");
        } else {
            asm volatile("buffer_inv sc1" ::: "memory");
            XB_SPIN(xb_ld(&bar[XB_XGEN(b.x)]) == gen, bar);
            asm volatile("" ::: "memory");
            asm volatile("s_waitcnt vmcnt(0)" ::: "memory");
        }
    }
    __syncthreads();
}


typedef f32x4 AccT[2][2][4][2];
#define RS_OF(ssqp, row, rl) ((u.pm == rs_pm) ? rsbuf[(rl)] : row_rs((ssqp), (row)))
#define IN_PH(k) (ph_lo <= (k) && (k) < ph_hi)
#define SEAM(k) do { if (IN_PH(k) && IN_PH((k) + 1)) xcd_barrier(xbar); } while (0)
#define GRID_SYNC() do { asm volatile("s_waitcnt vmcnt(0) lgkmcnt(0)" ::: "memory"); grid.sync(); asm volatile("buffer_inv sc1\n\ts_waitcnt vmcnt(0)" ::: "memory"); } while (0)

__device__ __forceinline__ float row_rs(const float* ssq, int row) {
    const f32x4* p = (const f32x4*)(ssq + (size_t)row * 16);
    const f32x4 s = (p[0] + p[1]) + (p[2] + p[3]);
    return rsqrtf(((s.x + s.y) + (s.z + s.w)) * (1.f / DM) + 1e-6f);
}
__device__ __forceinline__ u32x4 pack8(const f32x4 a, const f32x4 b) { u32x4 w; w.x = cvt_pk_bf16(a.x, a.y); w.y = cvt_pk_bf16(a.z, a.w); w.z = cvt_pk_bf16(b.x, b.y); w.w = cvt_pk_bf16(b.z, b.w); return w; }
__device__ __forceinline__ float sumsq4(const f32x4 a) { return (a.x * a.x + a.y * a.y) + (a.z * a.z + a.w * a.w); }

struct EpiZ {
    bf16_t* Z; float* gates; const float* ssq;
    __device__ __forceinline__ void operator()(const AccT& acc, const pg8::Unit& u, int wr, int wc, int fr, int fq, const LAS float* rsbuf, int rs_pm) const {
        const int row0 = u.pm * 256 + wr * 64 + fr;
        if (u.pn == 13) {
            if (wc == 0 && fq == 0) {
#pragma unroll
                for (int ai = 0; ai < 2; ++ai)
#pragma unroll
                    for (int m = 0; m < 4; ++m) { const int row = row0 + ai * 128 + m * 16; const float rs = RS_OF(ssq, row, ai * 128 + wr * 64 + m * 16 + fr);
                        *(f32x4*)(gates + (size_t)row * 8) = acc[ai][0][m][0] * rs; *(f32x4*)(gates + (size_t)row * 8 + 4) = acc[ai][0][m][1] * rs; }
            }
            return;
        }
        const int zc = u.pn * 256 + (u.pn >= 6 ? 256 : 0) + wc * 32 + 8 * fq;
#pragma unroll
        for (int ai = 0; ai < 2; ++ai)
#pragma unroll
            for (int m = 0; m < 4; ++m) { const int row = row0 + ai * 128 + m * 16; const float rs = RS_OF(ssq, row, ai * 128 + wr * 64 + m * 16 + fr); bf16_t* zp = Z + (size_t)row * ZS + zc;
#pragma unroll
                for (int bj = 0; bj < 2; ++bj) *(u32x4*)(zp + bj * 128) = pack8(acc[ai][bj][m][0] * rs, acc[ai][bj][m][1] * rs); }
    }
};
struct EpiRes {
    const bf16_t* base; bf16_t* xb; float* ssq_out;
    __device__ __forceinline__ void operator()(const AccT& acc, const pg8::Unit& u, int wr, int wc, int fr, int fq, const LAS float* rsbuf, int rs_pm) const {
        const int row0 = u.pm * 256 + wr * 64 + fr, col0 = u.pn * 256 + wc * 32 + 8 * fq;
#pragma unroll
        for (int ai = 0; ai < 2; ++ai)
#pragma unroll
            for (int m = 0; m < 4; ++m) { const int row = row0 + ai * 128 + m * 16; const size_t off = (size_t)row * DM + col0; float q = 0.f;
#pragma unroll
                for (int bj = 0; bj < 2; ++bj) { const u32x4 bw = *(const u32x4*)(base + off + bj * 128);
                    const f32x4 b0 = {bflo(bw.x), bfhi(bw.x), bflo(bw.y), bfhi(bw.y)}, b1 = {bflo(bw.z), bfhi(bw.z), bflo(bw.w), bfhi(bw.w)};
                    const f32x4 v0 = b0 + acc[ai][bj][m][0], v1 = b1 + acc[ai][bj][m][1];
                    *(u32x4*)(xb + off + bj * 128) = pack8(v0, v1);
                    q += sumsq4(v0) + sumsq4(v1); }
                q += __shfl_xor(q, 16); q += __shfl_xor(q, 32);
                if (fq == 0) ssq_out[(size_t)row * 16 + u.pn * 4 + wc] = q; }
    }
};
struct EpiSwiGLU {
    bf16_t* H; const float* ssq;
    __device__ __forceinline__ void operator()(const AccT& acc, const pg8::Unit& u, int wr, int wc, int fr, int fq, const LAS float* rsbuf, int rs_pm) const {
        const int row0 = u.pm * 256 + wr * 64 + fr, hc = u.pn * 128 + wc * 32 + 8 * fq;
#pragma unroll
        for (int ai = 0; ai < 2; ++ai)
#pragma unroll
            for (int m = 0; m < 4; ++m) { const int row = row0 + ai * 128 + m * 16; const float rs = RS_OF(ssq, row, ai * 128 + wr * 64 + m * 16 + fr);
                f32x4 h[2];
#pragma unroll
                for (int n = 0; n < 2; ++n) { const f32x4 g = acc[ai][0][m][n] * rs, up = acc[ai][1][m][n] * rs;
                    h[n].x = g.x * fsigmoid(g.x) * up.x; h[n].y = g.y * fsigmoid(g.y) * up.y; h[n].z = g.z * fsigmoid(g.z) * up.z; h[n].w = g.w * fsigmoid(g.w) * up.w; }
                *(u32x4*)(H + (size_t)row * DFF + hc) = pack8(h[0], h[1]); }
    }
};
struct EpiProj {
    bf16_t* proj;
    __device__ __forceinline__ void operator()(const AccT& acc, const pg8::Unit& u, int wr, int wc, int fr, int fq, const LAS float* rsbuf, int rs_pm) const {
        const int row0 = u.pm * 256 + wr * 64 + fr, col0 = u.pn * 256 + wc * 32 + 8 * fq;
#pragma unroll
        for (int ai = 0; ai < 2; ++ai)
#pragma unroll
            for (int m = 0; m < 4; ++m) { const size_t off = (size_t)(row0 + ai * 128 + m * 16) * DM + col0;
#pragma unroll
                for (int bj = 0; bj < 2; ++bj) *(u32x4*)(proj + off + bj * 128) = pack8(acc[ai][bj][m][0], acc[ai][bj][m][1]); }
    }
};
struct EpiPle {
    const bf16_t* xin; const bf16_t* proj; bf16_t* xb; const float* ssq_in; float* ssq_out;
    __device__ __forceinline__ void operator()(const AccT& acc, const pg8::Unit& u, int wr, int wc, int fr, int fq, const LAS float* rsbuf, int rs_pm) const {
        const int row0 = u.pm * 256 + wr * 64 + fr, col0 = u.pn * 256 + wc * 32 + 8 * fq;
#pragma unroll
        for (int ai = 0; ai < 2; ++ai)
#pragma unroll
            for (int m = 0; m < 4; ++m) { const int row = row0 + ai * 128 + m * 16; const size_t off = (size_t)row * DM + col0; const float rs = RS_OF(ssq_in, row, ai * 128 + wr * 64 + m * 16 + fr); float q = 0.f;
#pragma unroll
                for (int bj = 0; bj < 2; ++bj) { f32x4 v[2]; const u32x4 pw = *(const u32x4*)(proj + off + bj * 128), bw = *(const u32x4*)(xin + off + bj * 128);
#pragma unroll
                    for (int n = 0; n < 2; ++n) { const f32x4 a = acc[ai][bj][m][n] * rs;
                        const unsigned p0 = n == 0 ? pw.x : pw.z, p1 = n == 0 ? pw.y : pw.w, b0 = n == 0 ? bw.x : bw.z, b1 = n == 0 ? bw.y : bw.w;
                        const f32x4 pr = {bflo(p0), bfhi(p0), bflo(p1), bfhi(p1)}, b = {bflo(b0), bfhi(b0), bflo(b1), bfhi(b1)};
                        v[n].x = b.x + fsigmoid(a.x) * pr.x; v[n].y = b.y + fsigmoid(a.y) * pr.y; v[n].z = b.z + fsigmoid(a.z) * pr.z; v[n].w = b.w + fsigmoid(a.w) * pr.w; }
                    *(u32x4*)(xb + off + bj * 128) = pack8(v[0], v[1]);
                    q += sumsq4(v[0]) + sumsq4(v[1]);
                    }
                q += __shfl_xor(q, 16); q += __shfl_xor(q, 32);
                if (fq == 0) ssq_out[(size_t)row * 16 + u.pn * 4 + wc] = q; }
    }
};

__device__ __forceinline__ f32x4 mma_T(const LAS bf16_t* A, int lda, int arow0, const LAS bf16_t* B, int ldb, int brow0, int k0, f32x4 acc, int fr, int fq) {
    const bf16x8 a = *(const LAS bf16x8*)(A + (arow0 + fr) * lda + k0 + fq * 8);
    const bf16x8 b = *(const LAS bf16x8*)(B + (brow0 + fr) * ldb + k0 + fq * 8);
    return __builtin_amdgcn_mfma_f32_16x16x32_bf16(b, a, acc, 0, 0, 0);
}
__device__ __forceinline__ void unpack8(const u32x4 w, float (&f)[8]) { f[0] = bflo(w.x); f[1] = bfhi(w.x); f[2] = bflo(w.y); f[3] = bfhi(w.y); f[4] = bflo(w.z); f[5] = bfhi(w.z); f[6] = bflo(w.w); f[7] = bfhi(w.w); }
__device__ __forceinline__ u32x4 pack8f(const float (&f)[8]) { u32x4 w; w.x = cvt_pk_bf16(f[0], f[1]); w.y = cvt_pk_bf16(f[2], f[3]); w.z = cvt_pk_bf16(f[4], f[5]); w.w = cvt_pk_bf16(f[6], f[7]); return w; }
__device__ __forceinline__ void store_col8(LAS bf16_t* dst, int ld, int r0, int c, const float (&f)[8]) {
#pragma unroll
    for (int i = 0; i < 8; i += 2) { const unsigned w = cvt_pk_bf16(f[i], f[i + 1]); dst[(r0 + i) * ld + c] = (bf16_t)(w & 0xffffu); dst[(r0 + i + 1) * ld + c] = (bf16_t)(w >> 16); }
}

struct Ctx {
    const int* pos; const float *ret_gn, *conv_w, *conv_b, *b_i, *b_f, *ml_gn;
    bf16_t* Z; const float* gates; float* st_ret; float* st_ml; float* sA; float* sB; float* sM; const bf16_t* wpT; float* z0;
};

__device__ __forceinline__ void rope8(float posf, int p, float (&sn)[8], float (&cs)[8]) {
    const f32x4 f0 = *(const f32x4*)(INV_FREQ + 8 * p), f1 = *(const f32x4*)(INV_FREQ + 8 * p + 4);
    const float fr_[8] = {f0.x, f0.y, f0.z, f0.w, f1.x, f1.y, f1.z, f1.w};
#pragma unroll
    for (int i = 0; i < 8; ++i) { float rev = (posf * fr_[i]) * 0.15915494309189535f; rev = rev - floorf(rev); sn[i] = __builtin_amdgcn_sinf(rev); cs[i] = __builtin_amdgcn_cosf(rev); }
}

__device__ __forceinline__ void ret_item_A(LAS unsigned char* lds, const Ctx& X, int item, int tid) {
    asm volatile("" : "+v"(tid));
    const int lane = tid & 63, w = __builtin_amdgcn_readfirstlane(tid >> 6), fr = lane & 15, fq = lane >> 4;
    const int bh = item >> 6, n = item & 63, b = bh / 6, h = bh % 6, tok0 = b * SEQ + n * 128;
    const float l2g = l2gamma(h);
    LAS bf16_t* Kt = (LAS bf16_t*)lds; LAS bf16_t* Vt = Kt + 64 * 136;
    {
        const int c = tid >> 2, p = tid & 3, token = tok0 + c;
        const bf16_t* zr = X.Z + (size_t)token * ZS + h * 64;
        const u32x4 k1 = *(const u32x4*)(zr + ZK + 8 * p), k2 = *(const u32x4*)(zr + ZK + 32 + 8 * p);
        const u32x4 v1 = *(const u32x4*)(zr + ZV + 16 * p), v2 = *(const u32x4*)(zr + ZV + 16 * p + 8);
        float sn[8], cs[8]; rope8((float)X.pos[token], p, sn, cs);
        float a[8], bq[8], o1[8], o2[8]; unpack8(k1, a); unpack8(k2, bq);
        const float sc = 0.125f * exp2f((float)(127 - c) * l2g);
#pragma unroll
        for (int i = 0; i < 8; ++i) { o1[i] = (a[i] * cs[i] - bq[i] * sn[i]) * sc; o2[i] = (a[i] * sn[i] + bq[i] * cs[i]) * sc; }
        store_col8(Kt, 136, 8 * p, c, o1); store_col8(Kt, 136, 32 + 8 * p, c, o2);
        unpack8(v1, a); unpack8(v2, bq);
        store_col8(Vt, 136, 16 * p, c, a); store_col8(Vt, 136, 16 * p + 8, c, bq);
    }
    __syncthreads();
    float* dst = X.st_ret + (size_t)item * 4096;
#pragma unroll
    for (int i = 0; i < 2; ++i) { const int ti = 2 * w + i, mt = ti >> 2, nt = ti & 3; f32x4 acc = {0.f, 0.f, 0.f, 0.f};
#pragma unroll
        for (int ks = 0; ks < 4; ++ks) acc = mma_T(Vt, 136, mt * 16, Kt, 136, nt * 16, ks * 32, acc, fr, fq);
        *(f32x4*)(dst + (mt * 16 + fr) * 64 + nt * 16 + 4 * fq) = acc; }
    __syncthreads();
}

__device__ __forceinline__ void ml_gates(const Ctx& X, int tok0, int h, int lane, float& li0, float& li1, float& bc0, float& bc1, float& blast) {
    const float bi = X.b_i[h], bf = X.b_f[h];
    const float* g0 = X.gates + (size_t)(tok0 + 2 * lane) * 8;
    li0 = g0[h] + bi; li1 = g0[8 + h] + bi;
    const float x0 = g0[4 + h] + bf, x1 = g0[12 + h] + bf;
    const float lf0 = fminf(x0, 0.f) - log1pf(__expf(-fabsf(x0))), lf1 = fminf(x1, 0.f) - log1pf(__expf(-fabsf(x1)));
    const float s = wave_scan_sum(lf0 + lf1, lane);
    bc1 = s; bc0 = s - lf1; blast = __shfl(s, 63);
}
__device__ __forceinline__ void conv8(const bf16_t* zp, int tseq, const float* cw, const float* cb, float (&y)[8]) {
    const f32x4 b0 = *(const f32x4*)cb, b1 = *(const f32x4*)(cb + 4);
    y[0] = b0.x; y[1] = b0.y; y[2] = b0.z; y[3] = b0.w; y[4] = b1.x; y[5] = b1.y; y[6] = b1.z; y[7] = b1.w;
#pragma unroll
    for (int j = 0; j < 4; ++j) { const int dt = j - 3;
        if (tseq + dt >= 0) { const u32x4 raw = *(const u32x4*)(zp + (long)dt * ZS); float x[8]; unpack8(raw, x);
            const f32x4 w0 = *(const f32x4*)(cw + j * 768), w1 = *(const f32x4*)(cw + j * 768 + 4);
            y[0] += w0.x * x[0]; y[1] += w0.y * x[1]; y[2] += w0.z * x[2]; y[3] += w0.w * x[3]; y[4] += w1.x * x[4]; y[5] += w1.y * x[5]; y[6] += w1.z * x[6]; y[7] += w1.w * x[7]; } }
#pragma unroll
    for (int i = 0; i < 8; ++i) y[i] = y[i] * fsigmoid(y[i]);
}

__device__ __forceinline__ void ml_item_A(LAS unsigned char* lds, const Ctx& X, int item, int tid) {
    asm volatile("" : "+v"(tid));
    const int lane = tid & 63, w = __builtin_amdgcn_readfirstlane(tid >> 6), fr = lane & 15, fq = lane >> 4;
    const int bh = item >> 6, n = item & 63, b = bh >> 2, h = bh & 3, tok0 = b * SEQ + n * 128;
    LAS bf16_t* Kt = (LAS bf16_t*)lds; LAS bf16_t* Vt = Kt + 96 * 136; LAS float* wg = (LAS float*)(lds + 56576);
    if (w == 0) {
        float li0, li1, bc0, bc1, blast; ml_gates(X, tok0, h, lane, li0, li1, bc0, bc1, blast);
        const float lw0 = blast - bc0 + li0, lw1 = blast - bc1 + li1, a = wave_max(fmaxf(lw0, lw1));
        wg[2 * lane] = __expf(lw0 - a); wg[2 * lane + 1] = __expf(lw1 - a);
        if (lane == 0) { X.sA[item] = a; X.sB[item] = blast; }
    }
    __syncthreads();
#pragma unroll
    for (int i = 0; i < 3; ++i) { const int pair = tid + 512 * i, part = pair % 12, c = pair / 12, token = tok0 + c, ch = h * 96 + 8 * part;
        float y[8]; conv8(X.Z + (size_t)token * ZS + ZMK + ch, n * 128 + c, X.conv_w + 384 + ch, X.conv_b + 384 + ch, y);
        const float g = wg[c];
#pragma unroll
        for (int k = 0; k < 8; ++k) y[k] *= g;
        store_col8(Kt, 136, 8 * part, c, y);
        const u32x4 v = *(const u32x4*)(X.Z + (size_t)token * ZS + ZMV + ch); unpack8(v, y);
        store_col8(Vt, 136, 8 * part, c, y); }
    for (int i = tid; i < 16 * 128; i += 512) { const int r = i >> 7, c = i & 127; Vt[(96 + r) * 136 + c] = (bf16_t)(r == 0 ? 0x3f80u : 0u); }
    __syncthreads();
    float* dst = X.st_ml + (size_t)item * ML_ST;
#pragma unroll 1
    for (int ti = w; ti < 42; ti += 8) { const int mt = ti / 6, nt = ti % 6; f32x4 acc = {0.f, 0.f, 0.f, 0.f};
#pragma unroll
        for (int ks = 0; ks < 4; ++ks) acc = mma_T(Vt, 136, mt * 16, Kt, 136, nt * 16, ks * 32, acc, fr, fq);
        const int e = mt * 16 + fr;
        if (e < 97) *(f32x4*)(dst + e * 96 + nt * 16 + 4 * fq) = acc; }
    __syncthreads();
}

__device__ __forceinline__ void pool_item(LAS unsigned char* lds, const Ctx& X, int ci, int tid) {
    asm volatile("" : "+v"(tid));
    const int lane = tid & 63, w = __builtin_amdgcn_readfirstlane(tid >> 6), fr = lane & 15, fq = lane >> 4;
    const int tok0 = ci * 128, n = ci & 63;
    LAS bf16_t* Us = (LAS bf16_t*)lds; LAS bf16_t* Ws = (LAS bf16_t*)(lds + 76032); LAS bf16_t* Pl = (LAS bf16_t*)(lds + 112896);
    for (int i = tid; i < 143 * 32; i += 512) { const int r = i >> 5, cch = i & 31; const int tseq = n * 128 - 15 + r;
        u32x4 v = {0u, 0u, 0u, 0u}; if (tseq >= 0) v = *(const u32x4*)(X.Z + (size_t)(tok0 - 15 + r) * ZS + ZPU + 8 * cch);
        *(LAS u32x4*)(Us + r * 264 + 8 * cch) = v; }
    for (int i = tid; i < 2048; i += 512) { const int r = i >> 3, cch = i & 7; *(LAS u32x4*)(Ws + r * 72 + 8 * cch) = *(const u32x4*)(X.wpT + r * 64 + 8 * cch); }
    __syncthreads();
#pragma unroll 1
    for (int g = 0; g < 4; ++g) { const int win = 2 << g;
#pragma unroll 1
        for (int i = 0; i < 2; ++i) { const int task = tid + 512 * i, oct = task & 7, c = task >> 3; float s[8] = {0.f, 0.f, 0.f, 0.f, 0.f, 0.f, 0.f, 0.f}, x[8];
            const LAS bf16_t* up = Us + (15 + c) * 264 + g * 64 + 8 * oct;
            for (int j = 0; j < win; ++j) { unpack8(*(const LAS u32x4*)(up - j * 264), x);
#pragma unroll
                for (int k = 0; k < 8; ++k) s[k] += x[k]; }
            unpack8(*(const LAS u32x4*)up, x);
            const float inv = 1.f / fminf((float)(n * 128 + c + 1), (float)win);
#pragma unroll
            for (int k = 0; k < 8; ++k) s[k] = s[k] * inv - x[k];
            *(LAS u32x4*)(Pl + c * 72 + 8 * oct) = pack8f(s); }
        __syncthreads();
        f32x4 acc[4];
#pragma unroll
        for (int nt = 0; nt < 4; ++nt) { acc[nt] = (f32x4){0.f, 0.f, 0.f, 0.f};
#pragma unroll
            for (int ks = 0; ks < 2; ++ks) acc[nt] = mma_T(Pl, 72, 16 * w, Ws + g * 64 * 72, 72, 16 * nt, 32 * ks, acc[nt], fr, fq); }
        bf16_t* zo = X.Z + (size_t)(tok0 + 16 * w + fr) * ZS + ZYP + g * 64 + 4 * fq;
#pragma unroll
        for (int nt = 0; nt < 4; ++nt) { u32x2 o; o.x = cvt_pk_bf16(acc[nt].x, acc[nt].y); o.y = cvt_pk_bf16(acc[nt].z, acc[nt].w); *(u32x2*)(zo + 16 * nt) = o; }
        __syncthreads(); }
}


__device__ __forceinline__ void t0_item(LAS unsigned char* lds, const Ctx& X, int grp, const bool xf32, const float* x0, const float* x1, const bf16_t* xb0, const bf16_t* xb1, const float* win, const float* gmix, const float* ssq, int tid) {
    asm volatile("" : "+v"(tid));
    const int lane = tid & 63, w = __builtin_amdgcn_readfirstlane(tid >> 6), ksub = lane >> 5, cl = lane & 31;
    const int col = grp * 32 + cl, src_col = col < 768 ? col : 1792 + (col - 768);
    LAS float* red = (LAS float*)lds;
    float a0 = 0.f, a1 = 0.f;
    const float* wp = win + (size_t)(128 * w + ksub) * INW + src_col;
#pragma unroll 8
    for (int i = 0; i < 64; ++i) { const int k = 128 * w + 2 * i + ksub; const float wv = wp[(size_t)(2 * i) * INW] * gmix[k];
        float xa, xc; if (xf32) { xa = x0[k]; xc = x1[k]; } else { xa = bflo((unsigned)xb0[k]); xc = bflo((unsigned)xb1[k]); } a0 += xa * wv; a1 += xc * wv; }
    red[((w * 2 + ksub) * 2 + 0) * 32 + cl] = a0; red[((w * 2 + ksub) * 2 + 1) * 32 + cl] = a1;
    __syncthreads();
    if (tid < 64) { const int bb = tid >> 5; float s = 0.f;
#pragma unroll
        for (int j = 0; j < 16; ++j) s += red[(j * 2 + bb) * 32 + cl];
        X.z0[bb * 1536 + col] = s * row_rs(ssq, bb * SEQ); }
    __syncthreads();
}

__device__ __forceinline__ void scan_phase(const Ctx& X, int gtid, int nthreads) {
    asm volatile("" : "+v"(gtid));
    for (int idx = gtid; idx < 49152 + 8 * ML_ST; idx += nthreads) {
        if (idx < 49152) {
            const int bh = idx >> 12, el = idx & 4095, h = bh % 6; const float cd = exp2f(128.f * l2gamma(h));
            float* p = X.st_ret + (size_t)bh * 64 * 4096 + el; float st = 0.f;
#pragma unroll 1
            for (int n0 = 0; n0 < 64; n0 += 32) { float kv[32];
#pragma unroll
                for (int j = 0; j < 32; ++j) kv[j] = p[(size_t)(n0 + j) * 4096];
#pragma unroll
                for (int j = 0; j < 32; ++j) { p[(size_t)(n0 + j) * 4096] = st; st = cd * st + kv[j]; } }
        } else {
            const int j0 = idx - 49152, bh = j0 / ML_ST, el = j0 % ML_ST;
            float* p = X.st_ml + (size_t)bh * 64 * ML_ST + el; float st = 0.f, m = 0.f;
#pragma unroll 1
            for (int n0 = 0; n0 < 64; n0 += 32) { float kv[32];
#pragma unroll
                for (int j = 0; j < 32; ++j) kv[j] = p[(size_t)(n0 + j) * ML_ST];
#pragma unroll
                for (int j = 0; j < 32; ++j) { const int item = bh * 64 + n0 + j; const float a = X.sA[item], bl = X.sB[item];
                    p[(size_t)(n0 + j) * ML_ST] = st; if (el == 0) X.sM[item] = m;
                    const float mn = fmaxf(bl + m, a), so = __expf(bl + m - mn), sw = __expf(a - mn);
                    st = so * st + sw * kv[j]; m = mn; } }
        }
    }
}

__device__ __forceinline__ void ret_item_C(LAS unsigned char* lds, const Ctx& X, int item, int tid) {
    asm volatile("" : "+v"(tid));
    const int lane = tid & 63, w = __builtin_amdgcn_readfirstlane(tid >> 6), fr = lane & 15, fq = lane >> 4;
    const int bh = item >> 6, n = item & 63, b = bh / 6, h = bh % 6, tok0 = b * SEQ + n * 128;
    const float l2g = l2gamma(h);
    LAS bf16_t* Qs = (LAS bf16_t*)lds; LAS bf16_t* Ks = Qs + 128 * 72; LAS bf16_t* Vt = Ks + 128 * 72; LAS bf16_t* Ps = Vt + 64 * 136; LAS bf16_t* Rt = Ps + 128 * 136;
    bf16_t* gp = X.Z + (size_t)(tok0 + 16 * w + fr) * ZS + ZG + h * 64 + 4 * fq;
    u32x2 gpre[4];
#pragma unroll
    for (int nt = 0; nt < 4; ++nt) gpre[nt] = *(const u32x2*)(gp + 16 * nt);
    {
        const int c = tid >> 2, p = tid & 3, token = tok0 + c;
        const bf16_t* zr = X.Z + (size_t)token * ZS + h * 64;
        const u32x4 q1 = *(const u32x4*)(zr + ZQ + 8 * p), q2 = *(const u32x4*)(zr + ZQ + 32 + 8 * p);
        const u32x4 k1 = *(const u32x4*)(zr + ZK + 8 * p), k2 = *(const u32x4*)(zr + ZK + 32 + 8 * p);
        const u32x4 v1 = *(const u32x4*)(zr + ZV + 16 * p), v2 = *(const u32x4*)(zr + ZV + 16 * p + 8);
        const float* rsrc = X.st_ret + (size_t)item * 4096 + (tid >> 3) * 64 + (tid & 7) * 8;
        const f32x4 r0 = *(const f32x4*)rsrc, r1 = *(const f32x4*)(rsrc + 4);
        float sn[8], cs[8]; rope8((float)X.pos[token], p, sn, cs);
        float a[8], bq[8], o1[8], o2[8];
        unpack8(q1, a); unpack8(q2, bq);
#pragma unroll
        for (int i = 0; i < 8; ++i) { o1[i] = a[i] * cs[i] - bq[i] * sn[i]; o2[i] = a[i] * sn[i] + bq[i] * cs[i]; }
        *(LAS u32x4*)(Qs + c * 72 + 8 * p) = pack8f(o1); *(LAS u32x4*)(Qs + c * 72 + 32 + 8 * p) = pack8f(o2);
        unpack8(k1, a); unpack8(k2, bq);
#pragma unroll
        for (int i = 0; i < 8; ++i) { o1[i] = (a[i] * cs[i] - bq[i] * sn[i]) * 0.125f; o2[i] = (a[i] * sn[i] + bq[i] * cs[i]) * 0.125f; }
        *(LAS u32x4*)(Ks + c * 72 + 8 * p) = pack8f(o1); *(LAS u32x4*)(Ks + c * 72 + 32 + 8 * p) = pack8f(o2);
        unpack8(v1, a); unpack8(v2, bq);
        store_col8(Vt, 136, 16 * p, c, a); store_col8(Vt, 136, 16 * p + 8, c, bq);
        *(LAS u32x4*)(Rt + (tid >> 3) * 72 + (tid & 7) * 8) = pack8(r0, r1);
    }
    __syncthreads();
    const int nks = (w >> 1) + 1;
    const int crow = 16 * w + fr;
#pragma unroll
    for (int nt = 0; nt < 8; ++nt) {
        if (nt < 2 * nks) {
            f32x4 s = {0.f, 0.f, 0.f, 0.f};
            if (nt <= w) {
#pragma unroll
                for (int ks = 0; ks < 2; ++ks) s = mma_T(Qs, 72, 16 * w, Ks, 72, 16 * nt, 32 * ks, s, fr, fq);
                const int s0 = 16 * nt + 4 * fq; float pv[4] = {s.x, s.y, s.z, s.w};
#pragma unroll
                for (int j = 0; j < 4; ++j) { const int d = crow - (s0 + j); pv[j] = d >= 0 ? pv[j] * exp2f((float)d * l2g) : 0.f; }
                if (n == 0 && w == 0 && nt == 0) {
                    const float* zq = X.z0 + b * 1536 + h * 64 + lane;
                    const float p00 = wave_sum(zq[0] * zq[384]) * 0.125f;
                    if (lane == 0) pv[0] = p00; }
                s = (f32x4){pv[0], pv[1], pv[2], pv[3]};
            }
            u32x2 o; o.x = cvt_pk_bf16(s.x, s.y); o.y = cvt_pk_bf16(s.z, s.w);
            *(LAS u32x2*)(Ps + crow * 136 + 16 * nt + 4 * fq) = o;
        }
    }
    __syncthreads();
    f32x4 y[4];
    const float xi = exp2f((float)(crow + 1) * l2g);
#pragma unroll
    for (int nt = 0; nt < 4; ++nt) { y[nt] = (f32x4){0.f, 0.f, 0.f, 0.f};
#pragma unroll
        for (int ks = 0; ks < 2; ++ks) y[nt] = mma_T(Qs, 72, 16 * w, Rt, 72, 16 * nt, 32 * ks, y[nt], fr, fq);
        y[nt] = y[nt] * xi; }
#pragma unroll
    for (int ks = 0; ks < 4; ++ks) if (ks < nks) {
#pragma unroll
        for (int nt = 0; nt < 4; ++nt) y[nt] = mma_T(Ps, 136, 16 * w, Vt, 136, 16 * nt, 32 * ks, y[nt], fr, fq); }
    float sum = 0.f;
#pragma unroll
    for (int nt = 0; nt < 4; ++nt) sum += (y[nt].x + y[nt].y) + (y[nt].z + y[nt].w);
    sum += __shfl_xor(sum, 16); sum += __shfl_xor(sum, 32);
    const float mu = sum * (1.f / 64.f); float var = 0.f;
#pragma unroll
    for (int nt = 0; nt < 4; ++nt) { y[nt] = y[nt] - mu; var += sumsq4(y[nt]); }
    var += __shfl_xor(var, 16); var += __shfl_xor(var, 32);
    const float rstd = rsqrtf(var * (1.f / 64.f) + 1e-6f);
    const float* gn = X.ret_gn + h * 64 + 4 * fq;
#pragma unroll
    for (int nt = 0; nt < 4; ++nt) { const u32x2 gw = gpre[nt]; const f32x4 gg = *(const f32x4*)(gn + 16 * nt);
        const float g0 = bflo(gw.x), g1 = bfhi(gw.x), g2 = bflo(gw.y), g3 = bfhi(gw.y);
        const f32x4 o = y[nt] * rstd * gg;
        u32x2 ov; ov.x = cvt_pk_bf16(g0 * fsigmoid(g0) * o.x, g1 * fsigmoid(g1) * o.y); ov.y = cvt_pk_bf16(g2 * fsigmoid(g2) * o.z, g3 * fsigmoid(g3) * o.w);
        *(u32x2*)(gp + 16 * nt) = ov; }
    __syncthreads();
}

__device__ __forceinline__ void ml_item_C(LAS unsigned char* lds, const Ctx& X, int item, int tid) {
    asm volatile("" : "+v"(tid));
    const int lane = tid & 63, w = __builtin_amdgcn_readfirstlane(tid >> 6), fr = lane & 15, fq = lane >> 4;
    const int bh = item >> 6, n = item & 63, b = bh >> 2, h = bh & 3, tok0 = b * SEQ + n * 128;
    LAS bf16_t* Qs = (LAS bf16_t*)lds; LAS bf16_t* Ks = Qs + 128 * 104; LAS bf16_t* Vt = Ks + 128 * 104; LAS bf16_t* Ps = Vt + 112 * 136; LAS bf16_t* Ct = Ps + 128 * 136;
    LAS float* uS = (LAS float*)(lds + 141824); LAS float* MS = uS + 128; LAS float* inS = MS + 128; LAS float* emS = inS + 128;
    bf16_t* op = X.Z + (size_t)(tok0 + 16 * w + fr) * ZS + ZMO + h * 96 + 4 * fq;
    u32x2 opre[6];
#pragma unroll
    for (int nt = 0; nt < 6; ++nt) opre[nt] = *(const u32x2*)(op + 16 * nt);
    if (w == 0) {
        float li0, li1, bc0, bc1, blast; ml_gates(X, tok0, h, lane, li0, li1, bc0, bc1, blast);
        const float mprev = X.sM[item];
        const float u0 = li0 - bc0, u1 = li1 - bc1;
        const float incl = wave_scan_max(fmaxf(u0, u1), lane);
        float excl = __shfl_up(incl, 1); if (lane == 0) excl = -INFINITY;
        const float gm0 = fmaxf(excl, u0), gm1 = fmaxf(gm0, u1);
        const float M0 = fmaxf(mprev, gm0), M1 = fmaxf(mprev, gm1);
        uS[2 * lane] = u0; uS[2 * lane + 1] = u1; MS[2 * lane] = M0; MS[2 * lane + 1] = M1;
        inS[2 * lane] = __expf(mprev - M0); inS[2 * lane + 1] = __expf(mprev - M1);
        emS[2 * lane] = __expf(-(bc0 + M0)); emS[2 * lane + 1] = __expf(-(bc1 + M1));
    }
#pragma unroll
    for (int i = 0; i < 3; ++i) { const int pair = tid + 512 * i, part = pair % 12, c = pair / 12, token = tok0 + c, ch = h * 96 + 8 * part;
        float y[8]; conv8(X.Z + (size_t)token * ZS + ZMQ + ch, n * 128 + c, X.conv_w + ch, X.conv_b + ch, y);
#pragma unroll
        for (int k = 0; k < 8; ++k) y[k] *= 0.10206207261596577f;
        *(LAS u32x4*)(Qs + c * 104 + 8 * part) = pack8f(y);
        conv8(X.Z + (size_t)token * ZS + ZMK + ch, n * 128 + c, X.conv_w + 384 + ch, X.conv_b + 384 + ch, y);
        *(LAS u32x4*)(Ks + c * 104 + 8 * part) = pack8f(y);
        const u32x4 v = *(const u32x4*)(X.Z + (size_t)token * ZS + ZMV + ch); unpack8(v, y);
        store_col8(Vt, 136, 8 * part, c, y); }
    for (int i = tid; i < 16 * 128; i += 512) { const int r = i >> 7, c = i & 127; Vt[(96 + r) * 136 + c] = (bf16_t)(r == 0 ? 0x3f80u : 0u); }
    { const float* src = X.st_ml + (size_t)item * ML_ST;
      for (int i = tid; i < 97 * 12; i += 512) { const int e = i / 12, c8 = i % 12; const f32x4 a = *(const f32x4*)(src + e * 96 + 8 * c8), bq = *(const f32x4*)(src + e * 96 + 8 * c8 + 4);
          *(LAS u32x4*)(Ct + e * 104 + 8 * c8) = pack8(a, bq); }
      for (int i = tid; i < 15 * 12; i += 512) { const int e = 97 + i / 12, c8 = i % 12; *(LAS u32x4*)(Ct + e * 104 + 8 * c8) = (u32x4){0u, 0u, 0u, 0u}; } }
    __syncthreads();
    const int nks = (w >> 1) + 1;
    const int crow = 16 * w + fr;
    const float Mc = MS[crow];
#pragma unroll
    for (int nt = 0; nt < 8; ++nt) {
        if (nt < 2 * nks) {
            f32x4 s = {0.f, 0.f, 0.f, 0.f};
            if (nt <= w) {
#pragma unroll
                for (int ks = 0; ks < 3; ++ks) s = mma_T(Qs, 104, 16 * w, Ks, 104, 16 * nt, 32 * ks, s, fr, fq);
                const int s0 = 16 * nt + 4 * fq; float pv[4] = {s.x, s.y, s.z, s.w};
                const f32x4 us = *(const LAS f32x4*)(uS + s0); const float uu[4] = {us.x, us.y, us.z, us.w};
#pragma unroll
                for (int j = 0; j < 4; ++j) pv[j] = (s0 + j <= crow) ? pv[j] * __expf(uu[j] - Mc) : 0.f;
                if (n == 0 && w == 0 && nt == 0) {
                    const float* zq = X.z0 + b * 1536 + 768 + h * 96; const float* cwq = X.conv_w + 3 * 768 + h * 96; const float* cbq = X.conv_b + h * 96;
                    float part = 0.f;
#pragma unroll
                    for (int rep = 0; rep < 2; ++rep) { const int d = lane + 64 * rep;
                        if (d < 96) { float qv = cbq[d] + cwq[d] * zq[d], kv = cbq[384 + d] + cwq[384 + d] * zq[384 + d];
                            qv = qv * fsigmoid(qv) * 0.10206207261596577f; kv = kv * fsigmoid(kv); part += qv * kv; } }
                    const float s00 = wave_sum(part) * __expf(uS[0] - MS[0]);
                    if (lane == 0) pv[0] = s00; }
                s = (f32x4){pv[0], pv[1], pv[2], pv[3]};
            }
            u32x2 o; o.x = cvt_pk_bf16(s.x, s.y); o.y = cvt_pk_bf16(s.z, s.w);
            *(LAS u32x2*)(Ps + crow * 136 + 16 * nt + 4 * fq) = o;
        }
    }
    __syncthreads();
    f32x4 y[7];
    const float inter = inS[crow];
#pragma unroll
    for (int nt = 0; nt < 7; ++nt) { y[nt] = (f32x4){0.f, 0.f, 0.f, 0.f};
#pragma unroll
        for (int ks = 0; ks < 3; ++ks) y[nt] = mma_T(Qs, 104, 16 * w, Ct, 104, 16 * nt, 32 * ks, y[nt], fr, fq);
        y[nt] = y[nt] * inter; }
#pragma unroll
    for (int ks = 0; ks < 4; ++ks) if (ks < nks) {
#pragma unroll
        for (int nt = 0; nt < 7; ++nt) y[nt] = mma_T(Ps, 136, 16 * w, Vt, 136, 16 * nt, 32 * ks, y[nt], fr, fq); }
    const float den_raw = __shfl(y[6].x, fr);
    const float rden = 1.f / fmaxf(fabsf(den_raw), emS[crow]);
    float sum = 0.f;
#pragma unroll
    for (int nt = 0; nt < 6; ++nt) { y[nt] = y[nt] * rden; sum += (y[nt].x + y[nt].y) + (y[nt].z + y[nt].w); }
    sum += __shfl_xor(sum, 16); sum += __shfl_xor(sum, 32);
    const float mu = sum * (1.f / 96.f); float var = 0.f;
#pragma unroll
    for (int nt = 0; nt < 6; ++nt) { y[nt] = y[nt] - mu; var += sumsq4(y[nt]); }
    var += __shfl_xor(var, 16); var += __shfl_xor(var, 32);
    const float rstd = rsqrtf(var * (1.f / 96.f) + 1e-6f);
    const float* gn = X.ml_gn + h * 96 + 4 * fq;
#pragma unroll
    for (int nt = 0; nt < 6; ++nt) { const u32x2 ow = opre[nt]; const f32x4 gg = *(const f32x4*)(gn + 16 * nt);
        const f32x4 o = y[nt] * rstd * gg;
        u32x2 ov; ov.x = cvt_pk_bf16(fsigmoid(bflo(ow.x)) * o.x, fsigmoid(bfhi(ow.x)) * o.y); ov.y = cvt_pk_bf16(fsigmoid(bflo(ow.y)) * o.z, fsigmoid(bfhi(ow.y)) * o.w);
        *(u32x2*)(op + 16 * nt) = ov; }
    __syncthreads();
}

__device__ __forceinline__ void transpose_item(const float* W, int ldw, int src0, int nvalid, const float* gain, bf16_t* Bt, int K, int r0, int k0, LAS float* scr, int lane) {
    const int c4 = (lane & 15) * 4, kq = lane >> 4;
    f32x4 v[16];
#pragma unroll
    for (int i = 0; i < 16; ++i) { const int kk = 4 * i + kq; v[i] = (f32x4){0.f, 0.f, 0.f, 0.f};
        if (c4 < nvalid) v[i] = *(const f32x4*)(W + (size_t)(k0 + kk) * ldw + src0 + c4);
        if (gain) v[i] = v[i] * gain[k0 + kk]; }
#pragma unroll
    for (int i = 0; i < 16; ++i) { LAS float* d = scr + (4 * i + kq) * 65 + c4; d[0] = v[i].x; d[1] = v[i].y; d[2] = v[i].z; d[3] = v[i].w; }
    asm volatile("s_waitcnt lgkmcnt(0)" ::: "memory");
    const int c = lane & 7;
#pragma unroll
    for (int j = 0; j < 8; ++j) { const int nn = (lane >> 3) + 8 * j; const LAS float* s = scr + (8 * c) * 65 + nn;
        u32x4 o; o.x = cvt_pk_bf16(s[0 * 65], s[1 * 65]); o.y = cvt_pk_bf16(s[2 * 65], s[3 * 65]); o.z = cvt_pk_bf16(s[4 * 65], s[5 * 65]); o.w = cvt_pk_bf16(s[6 * 65], s[7 * 65]);
        *(u32x4*)(Bt + (size_t)(r0 + nn) * K + k0 + 8 * c) = o; }
    asm volatile("s_waitcnt lgkmcnt(0)" ::: "memory");
}

struct Params { const float* in[21]; float* out; unsigned char* ws; int ph_lo, ph_hi; };
template <class Tp> __device__ __forceinline__ Tp* launder(Tp* p) { asm volatile("" : "+s"(p)); return p; }
typedef const __attribute__((address_space(4))) Params* KArgs;
__device__ __forceinline__ KArgs kargs() { KArgs p = (KArgs)__builtin_amdgcn_kernarg_segment_ptr(); asm volatile("" : "+s"(p)); return p; }

__device__ __forceinline__ void convert_weights(const int l, const int i0, const int i1, const int gw, const int NGW, LAS float* scr, const int lane) {
    KArgs P = kargs(); unsigned char* wl = P->ws + (size_t)l * WL;
    for (int it = i0 + gw; it < i1; it += NGW) {
        int r = it;
        if (r < 896) { const int nb = r % 56, kb = r / 56, r0 = nb * 64;
            const int src0 = r0 < 1536 ? r0 : r0 < 1920 ? r0 + 1408 : r0 < 3072 ? r0 - 128 : r0 < 3328 ? r0 - 1536 : r0;
            const int nvalid = r0 < 3328 ? 64 : (r0 == 3328 ? 8 : 0);
            transpose_item(P->in[4] + (size_t)l * DM * INW, INW, src0 < INW ? src0 : 0, nvalid, P->in[3] + l * DM, (bf16_t*)(wl + O_WIN), DM, r0, kb * 64, scr, lane); continue; }
        r -= 896;
        if (r < 256) { const int nb = r % 16, kb = r / 16; transpose_item(P->in[13] + (size_t)l * DM * DM, DM, nb * 64, 64, nullptr, (bf16_t*)(wl + O_WOUT), DM, nb * 64, kb * 64, scr, lane); continue; }
        r -= 256;
        if (r < 1408) { const int nb = r % 88, kb = r / 88, r0 = nb * 64, tile = r0 >> 8, cc0 = r0 & 255, j0 = 128 * tile + (cc0 & 127), src0 = cc0 < 128 ? j0 : DFF + j0;
            transpose_item(P->in[15] + (size_t)l * DM * 2 * DFF, 2 * DFF, src0, 64, P->in[14] + l * DM, (bf16_t*)(wl + O_WGU), DM, r0, kb * 64, scr, lane); continue; }
        r -= 1408;
        if (r < 704) { const int nb = r % 16, kb = r / 16; transpose_item(P->in[16] + (size_t)l * DFF * DM, DM, nb * 64, 64, nullptr, (bf16_t*)(wl + O_WD), DFF, nb * 64, kb * 64, scr, lane); continue; }
        r -= 704;
        if (r < 256) { const int nb = r % 16, kb = r / 16; transpose_item(P->in[18] + (size_t)l * DM * DM, DM, nb * 64, 64, P->in[17] + l * DM, (bf16_t*)(wl + O_WPG), DM, nb * 64, kb * 64, scr, lane); continue; }
        r -= 256;
        { const int nb = r % 16, kb = r / 16; transpose_item(P->in[19] + (size_t)l * PLE * DM, DM, nb * 64, 64, nullptr, (bf16_t*)(wl + O_WPP), PLE, nb * 64, kb * 64, scr, lane); }
    }
}

__device__ __forceinline__ void convert_p(const int l, const int gw, const int NGW, const int lane) {
    KArgs P = kargs(); const float* src = P->in[1] + (size_t)l * T * PLE; bf16_t* dst = (bf16_t*)(P->ws + WS_PB) + (size_t)l * T * PLE;
    for (int m0 = 4 * gw; m0 < T * PLE / 1024; m0 += 4 * NGW) {
        f32x4 v[4][4];
#pragma unroll
        for (int r = 0; r < 4; ++r) { const f32x4* xr = (const f32x4*)(src + (size_t)(m0 + r) * 1024) + lane;
#pragma unroll
            for (int j = 0; j < 4; ++j) v[r][j] = xr[64 * j]; }
#pragma unroll
        for (int r = 0; r < 4; ++r) { u32x2* o = (u32x2*)(dst + (size_t)(m0 + r) * 1024) + lane;
#pragma unroll
            for (int j = 0; j < 4; ++j) { u32x2 w; w.x = cvt_pk_bf16(v[r][j].x, v[r][j].y); w.y = cvt_pk_bf16(v[r][j].z, v[r][j].w); o[64 * j] = w; } }
    }
}

__device__ __forceinline__ Ctx make_ctx(int l) {
    KArgs P = kargs(); unsigned char* ws = P->ws;
    Ctx X;
    X.pos = (const int*)P->in[2]; X.ret_gn = P->in[5] + l * 384; X.conv_w = P->in[8] + l * 3072; X.conv_b = P->in[9] + l * 768; X.b_i = P->in[10] + l * 4; X.b_f = P->in[11] + l * 4; X.ml_gn = P->in[12] + l * 384;
    X.Z = (bf16_t*)(ws + WS_Z); X.gates = (const float*)(ws + WS_GATES); X.st_ret = (float*)(ws + WS_ST); X.st_ml = (float*)(ws + WS_ST + ST_ML_OFF);
    X.sA = (float*)(ws + WS_SC); X.sB = X.sA + 512; X.sM = X.sA + 1024; X.z0 = (float*)(ws + WS_Z0); X.wpT = (const bf16_t*)(ws + (size_t)l * WL + O_WPT);
    return X;
}

__device__ __forceinline__ void run_layer(const int l, LAS unsigned char* lds, const XcdBarrier& xbar, const int G, const int ph_lo, const int ph_hi) {
    int tid = threadIdx.x; const int pb = 1 + 8 * l;
        if (IN_PH(pb + 0)) {
        { KArgs P = kargs(); unsigned char* ws = P->ws;
          pg8::Gemm g{(const bf16_t*)(ws + WS_XB0), (const bf16_t*)(ws + (size_t)l * WL + O_WIN), T, 3584, DM, DM, (const float*)(ws + WS_SSQ0)}; pg8::StaticOrder S; S.init(T, 3584, G, (int)blockIdx.x);
          EpiZ E{(bf16_t*)(ws + WS_Z), (float*)(ws + WS_GATES), (const float*)(ws + WS_SSQ0)}; pg8::gemm_phase<EpiZ, true>(lds, g, S, E);
          if (2 * (S.nwg % G) == G) {
              if ((int)blockIdx.x >= S.nwg % G) {
                  int t_ = threadIdx.x; asm volatile("" : "+v"(t_)); const int w_ = __builtin_amdgcn_readfirstlane(t_ >> 6), rem_ = S.nwg % G;
                  convert_p(l, ((int)blockIdx.x - rem_) * 8 + w_, (G - rem_) * 8, t_ & 63);
                  if (l == 0) convert_weights(1, 0, 1600, ((int)blockIdx.x - rem_) * 8 + w_, (G - rem_) * 8, (LAS float*)(lds + w_ * 16640), t_ & 63); }
          } else { int t_ = threadIdx.x; asm volatile("" : "+v"(t_)); const int w_ = __builtin_amdgcn_readfirstlane(t_ >> 6);
              convert_p(l, (int)blockIdx.x * 8 + w_, G * 8, t_ & 63);
              if (l == 0) convert_weights(1, 0, 1600, (int)blockIdx.x * 8 + w_, G * 8, (LAS float*)(lds + w_ * 16640), t_ & 63); } }
        }
        SEAM(pb + 0);
        if (IN_PH(pb + 1)) {
        { const Ctx X = make_ctx(l);
          for (int it = blockIdx.x; it < 1456; it += G) {
              if (it < 512) ml_item_A(lds, X, it, tid); else if (it < 1280) ret_item_A(lds, X, it - 512, tid); else if (it < 1408) pool_item(lds, X, it - 1280, tid);
              else { KArgs P = kargs(); const float* xs = P->in[0]; const bf16_t* xbs = (const bf16_t*)(P->ws + WS_XB0);
                     t0_item(lds, X, it - 1408, l == 0, xs, xs + (size_t)SEQ * DM, xbs, xbs + (size_t)SEQ * DM, P->in[4] + (size_t)l * DM * INW, P->in[3] + l * DM, (const float*)(P->ws + WS_SSQ0), tid); }
          } }
        }
        SEAM(pb + 1);
        if (IN_PH(pb + 2)) {
        { const Ctx X = make_ctx(l); scan_phase(X, blockIdx.x * 512 + tid, G * 512); }
        }
        SEAM(pb + 2);
        if (IN_PH(pb + 3)) {
        { const Ctx X = make_ctx(l);
          for (int it = blockIdx.x; it < 1280; it += G) {
              if (it < 512) ml_item_C(lds, X, it, tid); else ret_item_C(lds, X, it - 512, tid);
          } }
        }
        SEAM(pb + 3);
        if (IN_PH(pb + 4)) {
        { KArgs P = kargs(); unsigned char* ws = P->ws;
          pg8::Gemm g{(const bf16_t*)(ws + WS_Z) + ZG, (const bf16_t*)(ws + (size_t)l * WL + O_WOUT), T, DM, DM, ZS, nullptr}; pg8::StaticOrder S; S.init(T, DM, G, (int)blockIdx.x);
          EpiRes E{(const bf16_t*)(ws + WS_XB0), (bf16_t*)(ws + WS_XB0), (float*)(ws + WS_SSQ0)}; pg8::gemm_phase<EpiRes, true>(lds, g, S, E); }
        }
        SEAM(pb + 4);
        if (IN_PH(pb + 5)) {
        { KArgs P = kargs(); unsigned char* ws = P->ws;
          pg8::Gemm g{(const bf16_t*)(ws + WS_XB0), (const bf16_t*)(ws + (size_t)l * WL + O_WGU), T, 2 * DFF, DM, DM, (const float*)(ws + WS_SSQ0)}; pg8::StaticOrder S; S.init(T, 2 * DFF, G, (int)blockIdx.x);
          EpiSwiGLU E{(bf16_t*)(ws + WS_Z), (const float*)(ws + WS_SSQ0)}; pg8::gemm_phase<EpiSwiGLU, true>(lds, g, S, E);
          if (l == 0) { int t_ = threadIdx.x; asm volatile("" : "+v"(t_)); const int w_ = __builtin_amdgcn_readfirstlane(t_ >> 6), rem_ = S.nwg % G;
              if (2 * rem_ == G) { if ((int)blockIdx.x >= rem_) convert_weights(1, 1600, 3584, ((int)blockIdx.x - rem_) * 8 + w_, (G - rem_) * 8, (LAS float*)(lds + w_ * 16640), t_ & 63); }
              else convert_weights(1, 1600, 3584, (int)blockIdx.x * 8 + w_, G * 8, (LAS float*)(lds + w_ * 16640), t_ & 63); } }
        }
        SEAM(pb + 5);
        if (IN_PH(pb + 6)) {
        { KArgs P = kargs(); unsigned char* ws = P->ws;
          pg8::Gemm g{(const bf16_t*)(ws + WS_Z), (const bf16_t*)(ws + (size_t)l * WL + O_WD), T, DM, DFF, DFF, nullptr}; pg8::StaticOrder S; S.init(T, DM, G, (int)blockIdx.x);
          EpiRes E{(const bf16_t*)(ws + WS_XB0), (bf16_t*)(ws + WS_ST), (float*)(ws + WS_SSQ1)}; pg8::gemm_phase<EpiRes, true>(lds, g, S, E); }
        }
        SEAM(pb + 6);
        if (IN_PH(pb + 7)) {
        { KArgs P = kargs(); unsigned char* ws = P->ws;
          pg8::Gemm g{(const bf16_t*)(ws + WS_PB) + (size_t)l * T * PLE, (const bf16_t*)(ws + (size_t)l * WL + O_WPP), T, DM, PLE, PLE, nullptr}; pg8::StaticOrder S; S.init(T, DM, G, (int)blockIdx.x);
          EpiProj E{(bf16_t*)(ws + WS_Z)}; pg8::gemm_phase<EpiProj, true>(lds, g, S, E); }
        { KArgs P = kargs(); unsigned char* ws = P->ws;
          pg8::Gemm g{(const bf16_t*)(ws + WS_ST), (const bf16_t*)(ws + (size_t)l * WL + O_WPG), T, DM, DM, DM, (const float*)(ws + WS_SSQ1)}; pg8::StaticOrder S; S.init(T, DM, G, (int)blockIdx.x);
          EpiPle E{(const bf16_t*)(ws + WS_ST), (const bf16_t*)(ws + WS_Z), (bf16_t*)(ws + WS_XB0), (const float*)(ws + WS_SSQ1), (float*)(ws + WS_SSQ0)}; pg8::gemm_phase<EpiPle, true>(lds, g, S, E); }
        }
        SEAM(pb + 7);
    }

__global__ void __launch_bounds__(512, 2) fwd(Params Pun) {
    extern __shared__ __attribute__((aligned(16))) unsigned char lds_raw[];
    LAS unsigned char* lds = (LAS unsigned char*)lds_raw;
    cg::grid_group grid = cg::this_grid();
    const int tid = threadIdx.x, lane = tid & 63, wave = __builtin_amdgcn_readfirstlane(tid >> 6);
    const int G = gridDim.x;

    const int ph_lo = kargs()->ph_lo, ph_hi = kargs()->ph_hi;
    volatile LAS unsigned* bst = (volatile LAS unsigned*)(lds + LDS_BYTES - 16);
    if (tid == 0) { bst[0] = 0u; bst[1] = 0u; }
    __syncthreads();
    const XcdBarrier xbar = xcd_barrier_post((unsigned*)(kargs()->ws + WS_BAR), bst);
    if (IN_PH(0)) {
        KArgs P = kargs(); unsigned char* ws = P->ws;
        const int gw = blockIdx.x * 8 + wave, NGW = G * 8;
        LAS float* scr = (LAS float*)(lds + wave * 16640);
        convert_weights(0, 0, 3584, gw, NGW, scr, lane);
        bf16_t* XB0 = (bf16_t*)(ws + WS_XB0); float* SSQ0 = (float*)(ws + WS_SSQ0);
        for (int m0 = 4 * gw; m0 < T; m0 += 4 * NGW) {
            f32x4 v[4][4]; float s[4];
#pragma unroll
            for (int r = 0; r < 4; ++r) { const f32x4* xr = (const f32x4*)(P->in[0] + (size_t)(m0 + r) * DM) + lane;
#pragma unroll
                for (int j = 0; j < 4; ++j) v[r][j] = xr[64 * j]; }
#pragma unroll
            for (int r = 0; r < 4; ++r) { s[r] = 0.f;
#pragma unroll
                for (int j = 0; j < 4; ++j) s[r] += sumsq4(v[r][j]);
                s[r] = wave_sum(s[r]);
                u32x2* o = (u32x2*)(XB0 + (size_t)(m0 + r) * DM) + lane;
#pragma unroll
                for (int j = 0; j < 4; ++j) { u32x2 w; w.x = cvt_pk_bf16(v[r][j].x, v[r][j].y); w.y = cvt_pk_bf16(v[r][j].z, v[r][j].w); o[64 * j] = w; }
                if (lane < 16) SSQ0[(size_t)(m0 + r) * 16 + lane] = lane == 0 ? s[r] : 0.f; }
        }
        for (int o = blockIdx.x * 512 + tid; o < 2 * 16384; o += G * 512) {
            const int l = o >> 14, rem = o & 16383, g = rem >> 12, d = (rem >> 6) & 63, c = rem & 63;
            const float v = P->in[6][(size_t)l * 16384 + g * 4096 + c * 64 + d] * P->in[7][l * 256 + g * 64 + d];
            ((bf16_t*)(ws + (size_t)l * WL + O_WPT))[rem] = (bf16_t)(cvt_pk_bf16(v, v) & 0xffffu);
        }
    }
    if (ph_hi == 0x7fffffff) GRID_SYNC();
    SEAM(0);
    run_layer(0, lds, xbar, G, ph_lo, ph_hi);
    run_layer(1, lds, xbar, G, ph_lo, ph_hi);
    if (IN_PH(17)) { KArgs P = kargs(); float* outp = P->out; const bf16_t* xbf = (const bf16_t*)(P->ws + WS_XB0); const float* sq = (const float*)(P->ws + WS_SSQ0);
      const int gw = blockIdx.x * 8 + wave, NGW = G * 8;
      for (int m = gw; m < T; m += NGW) {
        const float rs = row_rs(sq, m);
        const u32x4* xr = (const u32x4*)(xbf + (size_t)m * DM) + lane;
        const f32x4* gp = (const f32x4*)(P->in[20]); f32x4* o = (f32x4*)(outp + (size_t)m * DM);
#pragma unroll
        for (int j = 0; j < 2; ++j) { const u32x4 w = xr[64 * j]; const int c4 = 2 * (lane + 64 * j);
            const f32x4 a = {bflo(w.x), bfhi(w.x), bflo(w.y), bfhi(w.y)}, b = {bflo(w.z), bfhi(w.z), bflo(w.w), bfhi(w.w)};
            o[c4] = a * rs * gp[c4]; o[c4 + 1] = b * rs * gp[c4 + 1]; }
      } }
}

extern "C" void kernel_launch(void* const* d_in, const int* in_sizes, int n_in, void* d_out, int out_size, void* d_ws, size_t ws_size, hipStream_t stream) {
    static int grid = 0;
    if (grid == 0) {
        if (n_in != 21 || out_size != T * DM || ws_size < WS_END) { fprintf(stderr, "kernel_launch: unexpected shapes (n_in %d out %d ws %zu, need %zu)\n", n_in, out_size, ws_size, (size_t)WS_END); grid = -1; return; }
        int dev = 0, cus = 0, per_cu = 0;
        (void)hipGetDevice(&dev);
        (void)hipDeviceGetAttribute(&cus, hipDeviceAttributeMultiprocessorCount, dev);
        (void)hipFuncSetAttribute((const void*)fwd, hipFuncAttributeMaxDynamicSharedMemorySize, LDS_BYTES);
        (void)hipOccupancyMaxActiveBlocksPerMultiprocessor(&per_cu, (const void*)fwd, 512, LDS_BYTES);
        if (per_cu < 1) per_cu = 1;
        grid = cus * per_cu;
    }
    if (grid < 0) return;
    Params p{};
    for (int i = 0; i < 21; ++i) p.in[i] = (const float*)d_in[i];
    p.out = (float*)d_out; p.ws = (unsigned char*)d_ws;
#if N_LAUNCHES == 1
    (void)hipMemsetAsync((char*)d_ws + WS_BAR, 0, 16384, stream);
    p.ph_lo = 0; p.ph_hi = 18;
    void* args[] = {&p};
    hipError_t e = hipLaunchCooperativeKernel((const void*)fwd, dim3(grid), dim3(512), args, LDS_BYTES, stream);
    if (e != hipSuccess) fprintf(stderr, "cooperative launch failed: %s (grid %d)\n", hipGetErrorString(e), grid);
#else
    for (int k = 0; k < 18; ++k) { p.ph_lo = k; p.ph_hi = k + 1; hipLaunchKernelGGL(fwd, dim3(grid), dim3(512), LDS_BYTES, stream, p); }
#endif
}
```

```cpp
#ifndef N_LAUNCHES
#define N_LAUNCHES 1
#endif
#include <hip/hip_runtime.h>
#include <hip/hip_cooperative_groups.h>
#include <cstdio>
#include <cstdint>
namespace cg = cooperative_groups;

#define LAS __attribute__((address_space(3)))
typedef unsigned short bf16_t;
typedef short bf16x8 __attribute__((ext_vector_type(8)));
typedef float f32x4 __attribute__((ext_vector_type(4)));
typedef unsigned u32x4 __attribute__((ext_vector_type(4)));
typedef unsigned u32x2 __attribute__((ext_vector_type(2)));

constexpr int T = 16384, DM = 1024, SEQ = 8192, DEPTH = 2, DFF = 2816, INW = 3336, PLE = 256;
constexpr int ZS = 3584;
constexpr int ZQ = 0, ZK = 384, ZV = 768, ZG = 1152, ZYP = 1536, ZMO = 1792, ZMQ = 2176, ZMK = 2560, ZMV = 2944, ZPU = 3328;
constexpr int LDS_BYTES = 147456;
constexpr size_t WL = 29392896;
constexpr size_t O_WIN = 0, O_WOUT = 7340032, O_WGU = 9437184, O_WD = 20971520, O_WPG = 26738688, O_WPP = 28835840, O_WPT = 29360128;
constexpr size_t WS_XB0 = 58785792, WS_Z = 92340224, WS_PB = 209780736, WS_ST = 226557952, WS_GATES = 260112384, WS_SSQ0 = 260636672, WS_SSQ1 = 261685248, WS_SC = 262733824, WS_Z0 = 262739968, WS_BAR = 262752256, WS_END = 262768640;
constexpr size_t ST_ML_OFF = 12582912;
constexpr int ML_ST = 9312;

__device__ const float INV_FREQ[32] = {
    1.000000000e+00f, 7.498942614e-01f, 5.623413324e-01f, 4.216965139e-01f, 3.162277639e-01f, 2.371373773e-01f, 1.778279394e-01f, 1.333521307e-01f,
    1.000000015e-01f, 7.498941571e-02f, 5.623413250e-02f, 4.216965288e-02f, 3.162277490e-02f, 2.371373773e-02f, 1.778279431e-02f, 1.333521493e-02f,
    9.999999776e-03f, 7.498941850e-03f, 5.623413250e-03f, 4.216964822e-03f, 3.162277630e-03f, 2.371373586e-03f, 1.778279431e-03f, 1.333521446e-03f,
    1.000000047e-03f, 7.498942432e-04f, 5.623413017e-04f, 4.216965172e-04f, 3.162277571e-04f, 2.371373703e-04f, 1.778279402e-04f, 1.333521504e-04f};

__device__ __forceinline__ float l2gamma(int h) {
    return h == 0 ? -0.04580368961312479f : h == 1 ? -0.02272007650008353f : h == 2 ? -0.011315313227834146f : h == 3 ? -0.005646563141142063f : h == 4 ? -0.0028205190623786626f : -0.0014095702546713536f;
}
typedef float f32x2v_ __attribute__((ext_vector_type(2)));
typedef __bf16 bf16x2v_ __attribute__((ext_vector_type(2)));
__device__ __forceinline__ unsigned cvt_pk_bf16(float lo, float hi) { const f32x2v_ v = {lo, hi}; const bf16x2v_ r = __builtin_convertvector(v, bf16x2v_); return __builtin_bit_cast(unsigned, r); }
__device__ __forceinline__ float bflo(unsigned w) { return __uint_as_float(w << 16); }
__device__ __forceinline__ float bfhi(unsigned w) { return __uint_as_float(w & 0xffff0000u); }
__device__ __forceinline__ float fsigmoid(float x) { return __builtin_amdgcn_rcpf(1.f + __expf(-x)); }
__device__ __forceinline__ float wave_sum(float v) {
#pragma unroll
    for (int o = 1; o < 64; o <<= 1) v += __shfl_xor(v, o);
    return v;
}
__device__ __forceinline__ float wave_max(float v) {
#pragma unroll
    for (int o = 1; o < 64; o <<= 1) v = fmaxf(v, __shfl_xor(v, o));
    return v;
}
__device__ __forceinline__ float wave_scan_sum(float v, int lane) {
#pragma unroll
    for (int o = 1; o < 64; o <<= 1) { const float t = __shfl_up(v, o); if (lane >= o) v += t; }
    return v;
}
__device__ __forceinline__ float wave_scan_max(float v, int lane) {
#pragma unroll
    for (int o = 1; o < 64; o <<= 1) { const float t = __shfl_up(v, o); if (lane >= o) v = fmaxf(v, t); }
    return v;
}

namespace pg8 {
__device__ __forceinline__ float row_rs_g(const float* ssq, int row) { const f32x4* p = (const f32x4*)(ssq + (size_t)row * 16); const f32x4 s = (p[0] + p[1]) + (p[2] + p[3]); return rsqrtf(((s.x + s.y) + (s.z + s.w)) * (1.f / 1024.f) + 1e-6f); }
constexpr int BM = 256, BK = 64, HALF = 128, HTB = HALF * BK * 2, STAGE_BYTES = 8 * HTB, NXCD = 8, WGM = 8;
__host__ __device__ __forceinline__ int lds_byte(int r, int c) { const int st = (r >> 4) * 2 + (c >> 5), rr = r & 15, cc = c & 31, ob = rr * 64 + cc * 2; return st * 1024 + (ob ^ (((ob >> 9) & 1) << 5)); }
__host__ __device__ __forceinline__ void stage_rc(int b, int& R, int& C) { const int st = b / 1024, sb = b % 1024, swz = sb ^ (((sb >> 9) & 1) << 5); R = (st >> 1) * 16 + swz / 64; C = (st & 1) * 32 + (swz % 64) / 2; }
__host__ __device__ __forceinline__ int perm32(int rho) { const int n = rho >> 4, i = rho & 15; return 8 * (i >> 2) + 4 * n + (i & 3); }

struct Unit { int pm, pn; };
struct Gemm { const bf16_t* A; const bf16_t* Bt; int M, N, K, lda; const float* ssq; };

struct StaticOrder {
    int nM, nN, nwg, G, c;
    __device__ void init(int M, int N, int G_, int c_) { nM = M / BM; nN = N / BM; nwg = nM * nN; G = G_; c = c_; }
    __device__ bool next(int i, Unit& u) const {
        const long L = (long)i * G + c; if (L >= nwg) return false;
        int wgid = (int)L; { const int q = nwg / NXCD, r = nwg % NXCD, xcd = wgid % NXCD, off = wgid / NXCD; wgid = (xcd < r ? xcd * (q + 1) : r * (q + 1) + (xcd - r) * q) + off; }
        const int nig = WGM * nN, gid = wgid / nig, fm = gid * WGM, gsz = (nM - fm) < WGM ? (nM - fm) : WGM;
        u.pm = fm + ((wgid % nig) % gsz); u.pn = (wgid % nig) / gsz; return true;
    }
};

template <class Epi, bool ALIGN_EPI>
__device__ __forceinline__ void gemm_phase(LAS unsigned char* lds, const Gemm g, const StaticOrder& S, const Epi& E) {
    int tid = threadIdx.x; asm volatile("" : "+v"(tid));
    const int wid = __builtin_amdgcn_readfirstlane(tid >> 6), lane = tid & 63, wr = wid >> 2, wc = wid & 3, fr = lane & 15, fq = lane >> 4;
    int K = g.K; asm volatile("" : "+s"(K));
    const int nt = K / BK, lda = g.lda;
    unsigned voffA[2], voffB[2];
#pragma unroll
    for (int i = 0; i < 2; ++i) { int R, C; stage_rc(tid * 16 + i * 8192, R, C); const int Rb = (R & ~31) + perm32(R & 31);
        voffA[i] = (unsigned)(R * lda + C) * 2u; voffB[i] = (unsigned)(Rb * K + C) * 2u; }
    const size_t kstep = (size_t)(BK * 2);
    const size_t hstepA = (size_t)HALF * lda * 2, tstepA = 2 * hstepA;
    const size_t hstepB = (size_t)HALF * K * 2, tstepB = 2 * hstepB;
    const unsigned ldsw = (unsigned)wid * 1024u;
    const int aoff = lds_byte(wr * 64 + fr, fq * 8), boff = lds_byte(wc * 32 + fr, fq * 8);
#define PG8_SA(b, h) (((b) * 2 + (h)) * HTB)
#define PG8_SB(b, h) ((4 + (b) * 2 + (h)) * HTB)
#define PG8_STAGE(bufoff, gbase, voff) do { _Pragma("unroll") for (int _i = 0; _i < 2; ++_i) \
        __builtin_amdgcn_global_load_lds((const unsigned*)((const char*)(gbase) + (voff)[_i]), (LAS unsigned*)(lds + (bufoff) + ldsw + _i * 8192), 16, 0, 0); } while (0)
#define PG8_LDA(dst, b, h) do { _Pragma("unroll") for (int m = 0; m < 4; ++m) _Pragma("unroll") for (int k = 0; k < 2; ++k) dst[m][k] = *(const LAS bf16x8*)(lds + PG8_SA(b, h) + aoff + m * 2048 + k * 1024); } while (0)
#define PG8_LDB(dst, b, h) do { _Pragma("unroll") for (int n = 0; n < 2; ++n) _Pragma("unroll") for (int k = 0; k < 2; ++k) dst[n][k] = *(const LAS bf16x8*)(lds + PG8_SB(b, h) + boff + n * 2048 + k * 1024); } while (0)
#define PG8_MMA(ai, bj, At, Bt) do { __builtin_amdgcn_s_setprio(1); _Pragma("unroll") for (int m = 0; m < 4; ++m) _Pragma("unroll") for (int n = 0; n < 2; ++n) _Pragma("unroll") for (int k = 0; k < 2; ++k) \
        acc[ai][bj][m][n] = __builtin_amdgcn_mfma_f32_16x16x32_bf16(Bt[n][k], At[m][k], acc[ai][bj][m][n], 0, 0, 0); __builtin_amdgcn_s_setprio(0); } while (0)
#define PG8_WAIT_V(n) asm volatile("s_waitcnt vmcnt(" #n ")" ::: "memory")
#define PG8_WAIT_L(n) asm volatile("s_waitcnt lgkmcnt(" #n ")" ::: "memory")
#define PG8_BAR __builtin_amdgcn_s_barrier()
#define PG8_SCHED __builtin_amdgcn_sched_barrier(0)
    Unit cur, nxt; int ui = 0;
    if (!S.next(0, cur)) return;
    LAS float* rsbuf = (LAS float*)(lds + STAGE_BYTES); int rs_pm = -1;
    if (g.ssq) { rs_pm = cur.pm; if (tid < 256) rsbuf[tid] = row_rs_g(g.ssq, cur.pm * 256 + tid); __syncthreads(); }
    f32x4 acc[2][2][4][2];
#pragma unroll
    for (int a = 0; a < 2; ++a)
#pragma unroll
        for (int b = 0; b < 2; ++b)
#pragma unroll
            for (int m = 0; m < 4; ++m)
#pragma unroll
                for (int n = 0; n < 2; ++n) acc[a][b][m][n] = (f32x4){0.f, 0.f, 0.f, 0.f};
    bf16x8 At[4][2], B0[2][2], B1[2][2];
    const char* cA = (const char*)g.A + (size_t)cur.pm * tstepA; const char* cB = (const char*)g.Bt + (size_t)cur.pn * tstepB;
    PG8_STAGE(PG8_SB(0, 0), cB, voffB); PG8_STAGE(PG8_SB(0, 1), cB + hstepB, voffB); PG8_STAGE(PG8_SA(0, 0), cA, voffA); PG8_STAGE(PG8_SA(0, 1), cA + hstepA, voffA);
    if (wr == 1) PG8_BAR;
    PG8_WAIT_V(2); PG8_BAR;
    PG8_STAGE(PG8_SB(1, 0), cB + kstep, voffB); PG8_STAGE(PG8_SA(1, 0), cA + kstep, voffA); PG8_STAGE(PG8_SB(1, 1), cB + hstepB + kstep, voffB);
    PG8_WAIT_V(6); PG8_BAR;
    for (;;) {
        const bool has_next = S.next(ui + 1, nxt);
        const char* nA = has_next ? (const char*)g.A + (size_t)nxt.pm * tstepA : cA; const char* nB = has_next ? (const char*)g.Bt + (size_t)nxt.pn * tstepB : cB;
        for (int t = 0; t < nt; t += 2) {
            const bool last = (t == nt - 2);
            const char* a1 = cA + (size_t)(t + 1) * kstep;
            const char* a2 = last ? nA : cA + (size_t)(t + 2) * kstep; const char* b2 = last ? nB : cB + (size_t)(t + 2) * kstep;
            const char* a3 = a2 + kstep; const char* b3 = b2 + kstep;
            PG8_LDB(B0, 0, 0); PG8_LDB(B1, 0, 1); PG8_SCHED; PG8_LDA(At, 0, 0); PG8_STAGE(PG8_SA(1, 1), a1 + hstepA, voffA);
            PG8_WAIT_V(8); PG8_WAIT_L(0); PG8_BAR; PG8_MMA(0, 0, At, B0); PG8_MMA(0, 1, At, B1); PG8_BAR; PG8_SCHED;
            PG8_LDA(At, 0, 1); PG8_STAGE(PG8_SB(0, 0), b2, voffB); PG8_STAGE(PG8_SB(0, 1), b2 + hstepB, voffB); PG8_STAGE(PG8_SA(0, 0), a2, voffA);
            PG8_WAIT_V(8); PG8_WAIT_L(0); PG8_BAR; PG8_MMA(1, 0, At, B0); PG8_MMA(1, 1, At, B1); PG8_BAR; PG8_SCHED;
            PG8_LDB(B0, 1, 0); PG8_LDB(B1, 1, 1); PG8_SCHED; PG8_LDA(At, 1, 0); PG8_STAGE(PG8_SA(0, 1), a2 + hstepA, voffA);
            PG8_WAIT_V(8); PG8_WAIT_L(0); PG8_BAR; PG8_MMA(0, 0, At, B0); PG8_MMA(0, 1, At, B1); PG8_BAR; PG8_SCHED;
            PG8_LDA(At, 1, 1); PG8_STAGE(PG8_SB(1, 0), b3, voffB); PG8_STAGE(PG8_SB(1, 1), b3 + hstepB, voffB); PG8_STAGE(PG8_SA(1, 0), a3, voffA);
            PG8_WAIT_V(8); PG8_WAIT_L(0); PG8_BAR; PG8_MMA(1, 0, At, B0); PG8_MMA(1, 1, At, B1); PG8_BAR; PG8_SCHED;
        }
        if constexpr (ALIGN_EPI) { if (wr == 0) PG8_BAR; }
        E(acc, cur, wr, wc, fr, fq, rsbuf, rs_pm);
        if (!has_next) break;
#pragma unroll
        for (int a = 0; a < 2; ++a)
#pragma unroll
            for (int b = 0; b < 2; ++b)
#pragma unroll
                for (int m = 0; m < 4; ++m)
#pragma unroll
                    for (int n = 0; n < 2; ++n) acc[a][b][m][n] = (f32x4){0.f, 0.f, 0.f, 0.f};
        cur = nxt; cA = nA; cB = nB; ++ui;
        if constexpr (ALIGN_EPI) { if (wr == 1) PG8_BAR; }
    }
    PG8_WAIT_V(0);
    if constexpr (!ALIGN_EPI) { if (wr == 0) PG8_BAR; }
    PG8_BAR;
#undef PG8_SA
#undef PG8_SB
#undef PG8_STAGE
#undef PG8_LDA
#undef PG8_LDB
#undef PG8_MMA
#undef PG8_WAIT_V
#undef PG8_WAIT_L
#undef PG8_BAR
#undef PG8_SCHED
}
}

#define XB_TMO      128
#define XB_XCNT(j)  (256  + 64 * (j))
#define XB_XSUB(j)  (1280 + 64 * (j))
#define XB_XGEN(j)  (2304 + 64 * (j))
#define XB_TOP      3328
#define XB_TOPGEN   3392
#define XCD_BAR_WORDS 3456
#define XB_SPIN_CAP (1u << 18)

__device__ __forceinline__ unsigned xb_ld(unsigned* p)              { return __hip_atomic_load(p, __ATOMIC_RELAXED, __HIP_MEMORY_SCOPE_AGENT); }
__device__ __forceinline__ unsigned xb_add(unsigned* p, unsigned v) { return __hip_atomic_fetch_add(p, v, __ATOMIC_RELAXED, __HIP_MEMORY_SCOPE_AGENT); }
__device__ __forceinline__ unsigned xb_xcc_id() { return (unsigned)__builtin_amdgcn_s_getreg((3 << 11) | 20) & 0xFu; }
#define XB_SPIN(cond, bar) do { unsigned _sp = 0; while (cond) { __builtin_amdgcn_s_sleep(1); \
    if ((++_sp & 255u) == 0u) { if (xb_ld(&(bar)[XB_TMO])) break; if (_sp > XB_SPIN_CAP) { atomicAdd(&(bar)[XB_TMO], 1u); break; } } } } while (0)

struct XcdBarrier {
    unsigned* bar; unsigned x;
    volatile LAS unsigned* st;
};

__device__ __forceinline__ XcdBarrier xcd_barrier_post(unsigned* bar, volatile LAS unsigned* st) {
    XcdBarrier b; b.bar = bar; b.x = xb_xcc_id(); b.st = st;
    if (threadIdx.x == 0) (void)xb_add(&bar[XB_XCNT(b.x)], 1u);
    return b;
}
__device__ __forceinline__ void xcd_barrier_complete(unsigned* bar, unsigned x, unsigned& nloc, unsigned& nx) {
    const unsigned G = gridDim.x * gridDim.y * gridDim.z;
    unsigned sum, cnt, mine, sp = 0u;
    for (;;) {
        sum = 0u; cnt = 0u; mine = 0u;
#pragma unroll
        for (unsigned j = 0; j < 16; ++j) { const unsigned c = xb_ld(&bar[XB_XCNT(j)]); sum += c; cnt += (c > 0u) ? 1u : 0u; mine = (j == x) ? c : mine; }
        if (sum == G) break;
        __builtin_amdgcn_s_sleep(1);
        if ((++sp & 255u) == 0u) { if (xb_ld(&bar[XB_TMO])) break; if (sp > XB_SPIN_CAP) { atomicAdd(&bar[XB_TMO], 1u); break; } }
    }
    nloc = mine > 0u ? mine : 1u; nx = cnt > 0u ? cnt : 1u;
}

__device__ __forceinline__ void xcd_barrier(const XcdBarrier& b) {
    asm volatile("s_waitcnt vmcnt(0)" ::: "memory");
    __syncthreads();
    if (threadIdx.x == 0) {
        unsigned* bar = b.bar;
        __builtin_amdgcn_s_waitcnt(0);
        unsigned nloc = b.st[0], nx = b.st[1];
        if (nloc == 0u) { xcd_barrier_complete(bar, b.x, nloc, nx); b.st[0] = nloc; b.st[1] = nx; }
        const unsigned old = xb_add(&bar[XB_XSUB(b.x)], 1u);
        const unsigned gen = old / nloc;
        if (old + 1u == (gen + 1u) * nloc) {
            __builtin_amdgcn_fence(__ATOMIC_RELEASE, "agent");
            asm volatile("s_waitcnt vmcnt(0)" ::: "memory");
            const unsigned og = xb_add(&bar[XB_TOP], 1u);
            const unsigned tg = og / nx;
            if (og + 1u == (tg + 1u) * nx) xb_add(&bar[XB_TOPGEN], 1u);
            else XB_SPIN(xb_ld(&bar[XB_TOPGEN]) == tg, bar);
            __builtin_amdgcn_fence(__ATOMIC_ACQUIRE, "agent");
            xb_add(&bar[XB_XGEN(b.x)], 1u);
            asm volatile("s_waitcnt vmcnt(0)" ::: "memory");
        } else {
            asm volatile("buffer_inv sc1" ::: "memory");
            XB_SPIN(xb_ld(&bar[XB_XGEN(b.x)]) == gen, bar);
            asm volatile("" ::: "memory");
            asm volatile("s_waitcnt vmcnt(0)" ::: "memory");
        }
    }
    __syncthreads();
}


typedef f32x4 AccT[2][2][4][2];
#define RS_OF(ssqp, row, rl) ((u.pm == rs_pm) ? rsbuf[(rl)] : row_rs((ssqp), (row)))
#define IN_PH(k) (ph_lo <= (k) && (k) < ph_hi)
#define SEAM(k) do { if (IN_PH(k) && IN_PH((k) + 1)) xcd_barrier(xbar); } while (0)
#define GRID_SYNC() do { asm volatile("s_waitcnt vmcnt(0) lgkmcnt(0)" ::: "memory"); grid.sync(); asm volatile("buffer_inv sc1\n\ts_waitcnt vmcnt(0)" ::: "memory"); } while (0)

__device__ __forceinline__ float row_rs(const float* ssq, int row) {
    const f32x4* p = (const f32x4*)(ssq + (size_t)row * 16);
    const f32x4 s = (p[0] + p[1]) + (p[2] + p[3]);
    return rsqrtf(((s.x + s.y) + (s.z + s.w)) * (1.f / DM) + 1e-6f);
}
__device__ __forceinline__ u32x4 pack8(const f32x4 a, const f32x4 b) { u32x4 w; w.x = cvt_pk_bf16(a.x, a.y); w.y = cvt_pk_bf16(a.z, a.w); w.z = cvt_pk_bf16(b.x, b.y); w.w = cvt_pk_bf16(b.z, b.w); return w; }
__device__ __forceinline__ float sumsq4(const f32x4 a) { return (a.x * a.x + a.y * a.y) + (a.z * a.z + a.w * a.w); }

struct EpiZ {
    bf16_t* Z; float* gates; const float* ssq;
    __device__ __forceinline__ void operator()(const AccT& acc, const pg8::Unit& u, int wr, int wc, int fr, int fq, const LAS float* rsbuf, int rs_pm) const {
        const int row0 = u.pm * 256 + wr * 64 + fr;
        if (u.pn == 13) {
            if (wc == 0 && fq == 0) {
#pragma unroll
                for (int ai = 0; ai < 2; ++ai)
#pragma unroll
                    for (int m = 0; m < 4; ++m) { const int row = row0 + ai * 128 + m * 16; const float rs = RS_OF(ssq, row, ai * 128 + wr * 64 + m * 16 + fr);
                        *(f32x4*)(gates + (size_t)row * 8) = acc[ai][0][m][0] * rs; *(f32x4*)(gates + (size_t)row * 8 + 4) = acc[ai][0][m][1] * rs; }
            }
            return;
        }
        const int zc = u.pn * 256 + (u.pn >= 6 ? 256 : 0) + wc * 32 + 8 * fq;
#pragma unroll
        for (int ai = 0; ai < 2; ++ai)
#pragma unroll
            for (int m = 0; m < 4; ++m) { const int row = row0 + ai * 128 + m * 16; const float rs = RS_OF(ssq, row, ai * 128 + wr * 64 + m * 16 + fr); bf16_t* zp = Z + (size_t)row * ZS + zc;
#pragma unroll
                for (int bj = 0; bj < 2; ++bj) *(u32x4*)(zp + bj * 128) = pack8(acc[ai][bj][m][0] * rs, acc[ai][bj][m][1] * rs); }
    }
};
struct EpiRes {
    const bf16_t* base; bf16_t* xb; float* ssq_out;
    __device__ __forceinline__ void operator()(const AccT& acc, const pg8::Unit& u, int wr, int wc, int fr, int fq, const LAS float* rsbuf, int rs_pm) const {
        const int row0 = u.pm * 256 + wr * 64 + fr, col0 = u.pn * 256 + wc * 32 + 8 * fq;
#pragma unroll
        for (int ai = 0; ai < 2; ++ai)
#pragma unroll
            for (int m = 0; m < 4; ++m) { const int row = row0 + ai * 128 + m * 16; const size_t off = (size_t)row * DM + col0; float q = 0.f;
#pragma unroll
                for (int bj = 0; bj < 2; ++bj) { const u32x4 bw = *(const u32x4*)(base + off + bj * 128);
                    const f32x4 b0 = {bflo(bw.x), bfhi(bw.x), bflo(bw.y), bfhi(bw.y)}, b1 = {bflo(bw.z), bfhi(bw.z), bflo(bw.w), bfhi(bw.w)};
                    const f32x4 v0 = b0 + acc[ai][bj][m][0], v1 = b1 + acc[ai][bj][m][1];
                    *(u32x4*)(xb + off + bj * 128) = pack8(v0, v1);
                    q += sumsq4(v0) + sumsq4(v1); }
                q += __shfl_xor(q, 16); q += __shfl_xor(q, 32);
                if (fq == 0) ssq_out[(size_t)row * 16 + u.pn * 4 + wc] = q; }
    }
};
struct EpiSwiGLU {
    bf16_t* H; const float* ssq;
    __device__ __forceinline__ void operator()(const AccT& acc, const pg8::Unit& u, int wr, int wc, int fr, int fq, const LAS float* rsbuf, int rs_pm) const {
        const int row0 = u.pm * 256 + wr * 64 + fr, hc = u.pn * 128 + wc * 32 + 8 * fq;
#pragma unroll
        for (int ai = 0; ai < 2; ++ai)
#pragma unroll
            for (int m = 0; m < 4; ++m) { const int row = row0 + ai * 128 + m * 16; const float rs = RS_OF(ssq, row, ai * 128 + wr * 64 + m * 16 + fr);
                f32x4 h[2];
#pragma unroll
                for (int n = 0; n < 2; ++n) { const f32x4 g = acc[ai][0][m][n] * rs, up = acc[ai][1][m][n] * rs;
                    h[n].x = g.x * fsigmoid(g.x) * up.x; h[n].y = g.y * fsigmoid(g.y) * up.y; h[n].z = g.z * fsigmoid(g.z) * up.z; h[n].w = g.w * fsigmoid(g.w) * up.w; }
                *(u32x4*)(H + (size_t)row * DFF + hc) = pack8(h[0], h[1]); }
    }
};
struct EpiProj {
    bf16_t* proj;
    __device__ __forceinline__ void operator()(const AccT& acc, const pg8::Unit& u, int wr, int wc, int fr, int fq, const LAS float* rsbuf, int rs_pm) const {
        const int row0 = u.pm * 256 + wr * 64 + fr, col0 = u.pn * 256 + wc * 32 + 8 * fq;
#pragma unroll
        for (int ai = 0; ai < 2; ++ai)
#pragma unroll
            for (int m = 0; m < 4; ++m) { const size_t off = (size_t)(row0 + ai * 128 + m * 16) * DM + col0;
#pragma unroll
                for (int bj = 0; bj < 2; ++bj) *(u32x4*)(proj + off + bj * 128) = pack8(acc[ai][bj][m][0], acc[ai][bj][m][1]); }
    }
};
struct EpiPle {
    const bf16_t* xin; const bf16_t* proj; bf16_t* xb; const float* ssq_in; float* ssq_out;
    __device__ __forceinline__ void operator()(const AccT& acc, const pg8::Unit& u, int wr, int wc, int fr, int fq, const LAS float* rsbuf, int rs_pm) const {
        const int row0 = u.pm * 256 + wr * 64 + fr, col0 = u.pn * 256 + wc * 32 + 8 * fq;
#pragma unroll
        for (int ai = 0; ai < 2; ++ai)
#pragma unroll
            for (int m = 0; m < 4; ++m) { const int row = row0 + ai * 128 + m * 16; const size_t off = (size_t)row * DM + col0; const float rs = RS_OF(ssq_in, row, ai * 128 + wr * 64 + m * 16 + fr); float q = 0.f;
#pragma unroll
                for (int bj = 0; bj < 2; ++bj) { f32x4 v[2]; const u32x4 pw = *(const u32x4*)(proj + off + bj * 128), bw = *(const u32x4*)(xin + off + bj * 128);
#pragma unroll
                    for (int n = 0; n < 2; ++n) { const f32x4 a = acc[ai][bj][m][n] * rs;
                        const unsigned p0 = n == 0 ? pw.x : pw.z, p1 = n == 0 ? pw.y : pw.w, b0 = n == 0 ? bw.x : bw.z, b1 = n == 0 ? bw.y : bw.w;
                        const f32x4 pr = {bflo(p0), bfhi(p0), bflo(p1), bfhi(p1)}, b = {bflo(b0), bfhi(b0), bflo(b1), bfhi(b1)};
                        v[n].x = b.x + fsigmoid(a.x) * pr.x; v[n].y = b.y + fsigmoid(a.y) * pr.y; v[n].z = b.z + fsigmoid(a.z) * pr.z; v[n].w = b.w + fsigmoid(a.w) * pr.w; }
                    *(u32x4*)(xb + off + bj * 128) = pack8(v[0], v[1]);
                    q += sumsq4(v[0]) + sumsq4(v[1]);
                    }
                q += __shfl_xor(q, 16); q += __shfl_xor(q, 32);
                if (fq == 0) ssq_out[(size_t)row * 16 + u.pn * 4 + wc] = q; }
    }
};

__device__ __forceinline__ f32x4 mma_T(const LAS bf16_t* A, int lda, int arow0, const LAS bf16_t* B, int ldb, int brow0, int k0, f32x4 acc, int fr, int fq) {
    const bf16x8 a = *(const LAS bf16x8*)(A + (arow0 + fr) * lda + k0 + fq * 8);
    const bf16x8 b = *(const LAS bf16x8*)(B + (brow0 + fr) * ldb + k0 + fq * 8);
    return __builtin_amdgcn_mfma_f32_16x16x32_bf16(b, a, acc, 0, 0, 0);
}
__device__ __forceinline__ void unpack8(const u32x4 w, float (&f)[8]) { f[0] = bflo(w.x); f[1] = bfhi(w.x); f[2] = bflo(w.y); f[3] = bfhi(w.y); f[4] = bflo(w.z); f[5] = bfhi(w.z); f[6] = bflo(w.w); f[7] = bfhi(w.w); }
__device__ __forceinline__ u32x4 pack8f(const float (&f)[8]) { u32x4 w; w.x = cvt_pk_bf16(f[0], f[1]); w.y = cvt_pk_bf16(f[2], f[3]); w.z = cvt_pk_bf16(f[4], f[5]); w.w = cvt_pk_bf16(f[6], f[7]); return w; }
__device__ __forceinline__ void store_col8(LAS bf16_t* dst, int ld, int r0, int c, const float (&f)[8]) {
#pragma unroll
    for (int i = 0; i < 8; i += 2) { const unsigned w = cvt_pk_bf16(f[i], f[i + 1]); dst[(r0 + i) * ld + c] = (bf16_t)(w & 0xffffu); dst[(r0 + i + 1) * ld + c] = (bf16_t)(w >> 16); }
}

struct Ctx {
    const int* pos; const float *ret_gn, *conv_w, *conv_b, *b_i, *b_f, *ml_gn;
    bf16_t* Z; const float* gates; float* st_ret; float* st_ml; float* sA; float* sB; float* sM; const bf16_t* wpT; float* z0;
};

__device__ __forceinline__ void rope8(float posf, int p, float (&sn)[8], float (&cs)[8]) {
    const f32x4 f0 = *(const f32x4*)(INV_FREQ + 8 * p), f1 = *(const f32x4*)(INV_FREQ + 8 * p + 4);
    const float fr_[8] = {f0.x, f0.y, f0.z, f0.w, f1.x, f1.y, f1.z, f1.w};
#pragma unroll
    for (int i = 0; i < 8; ++i) { float rev = (posf * fr_[i]) * 0.15915494309189535f; rev = rev - floorf(rev); sn[i] = __builtin_amdgcn_sinf(rev); cs[i] = __builtin_amdgcn_cosf(rev); }
}

__device__ __forceinline__ void ret_item_A(LAS unsigned char* lds, const Ctx& X, int item, int tid) {
    asm volatile("" : "+v"(tid));
    const int lane = tid & 63, w = __builtin_amdgcn_readfirstlane(tid >> 6), fr = lane & 15, fq = lane >> 4;
    const int bh = item >> 6, n = item & 63, b = bh / 6, h = bh % 6, tok0 = b * SEQ + n * 128;
    const float l2g = l2gamma(h);
    LAS bf16_t* Kt = (LAS bf16_t*)lds; LAS bf16_t* Vt = Kt + 64 * 136;
    {
        const int c = tid >> 2, p = tid & 3, token = tok0 + c;
        const bf16_t* zr = X.Z + (size_t)token * ZS + h * 64;
        const u32x4 k1 = *(const u32x4*)(zr + ZK + 8 * p), k2 = *(const u32x4*)(zr + ZK + 32 + 8 * p);
        const u32x4 v1 = *(const u32x4*)(zr + ZV + 16 * p), v2 = *(const u32x4*)(zr + ZV + 16 * p + 8);
        float sn[8], cs[8]; rope8((float)X.pos[token], p, sn, cs);
        float a[8], bq[8], o1[8], o2[8]; unpack8(k1, a); unpack8(k2, bq);
        const float sc = 0.125f * exp2f((float)(127 - c) * l2g);
#pragma unroll
        for (int i = 0; i < 8; ++i) { o1[i] = (a[i] * cs[i] - bq[i] * sn[i]) * sc; o2[i] = (a[i] * sn[i] + bq[i] * cs[i]) * sc; }
        store_col8(Kt, 136, 8 * p, c, o1); store_col8(Kt, 136, 32 + 8 * p, c, o2);
        unpack8(v1, a); unpack8(v2, bq);
        store_col8(Vt, 136, 16 * p, c, a); store_col8(Vt, 136, 16 * p + 8, c, bq);
    }
    __syncthreads();
    float* dst = X.st_ret + (size_t)item * 4096;
#pragma unroll
    for (int i = 0; i < 2; ++i) { const int ti = 2 * w + i, mt = ti >> 2, nt = ti & 3; f32x4 acc = {0.f, 0.f, 0.f, 0.f};
#pragma unroll
        for (int ks = 0; ks < 4; ++ks) acc = mma_T(Vt, 136, mt * 16, Kt, 136, nt * 16, ks * 32, acc, fr, fq);
        *(f32x4*)(dst + (mt * 16 + fr) * 64 + nt * 16 + 4 * fq) = acc; }
    __syncthreads();
}

__device__ __forceinline__ void ml_gates(const Ctx& X, int tok0, int h, int lane, float& li0, float& li1, float& bc0, float& bc1, float& blast) {
    const float bi = X.b_i[h], bf = X.b_f[h];
    const float* g0 = X.gates + (size_t)(tok0 + 2 * lane) * 8;
    li0 = g0[h] + bi; li1 = g0[8 + h] + bi;
    const float x0 = g0[4 + h] + bf, x1 = g0[12 + h] + bf;
    const float lf0 = fminf(x0, 0.f) - log1pf(__expf(-fabsf(x0))), lf1 = fminf(x1, 0.f) - log1pf(__expf(-fabsf(x1)));
    const float s = wave_scan_sum(lf0 + lf1, lane);
    bc1 = s; bc0 = s - lf1; blast = __shfl(s, 63);
}
__device__ __forceinline__ void conv8(const bf16_t* zp, int tseq, const float* cw, const float* cb, float (&y)[8]) {
    const f32x4 b0 = *(const f32x4*)cb, b1 = *(const f32x4*)(cb + 4);
    y[0] = b0.x; y[1] = b0.y; y[2] = b0.z; y[3] = b0.w; y[4] = b1.x; y[5] = b1.y; y[6] = b1.z; y[7] = b1.w;
#pragma unroll
    for (int j = 0; j < 4; ++j) { const int dt = j - 3;
        if (tseq + dt >= 0) { const u32x4 raw = *(const u32x4*)(zp + (long)dt * ZS); float x[8]; unpack8(raw, x);
            const f32x4 w0 = *(const f32x4*)(cw + j * 768), w1 = *(const f32x4*)(cw + j * 768 + 4);
            y[0] += w0.x * x[0]; y[1] += w0.y * x[1]; y[2] += w0.z * x[2]; y[3] += w0.w * x[3]; y[4] += w1.x * x[4]; y[5] += w1.y * x[5]; y[6] += w1.z * x[6]; y[7] += w1.w * x[7]; } }
#pragma unroll
    for (int i = 0; i < 8; ++i) y[i] = y[i] * fsigmoid(y[i]);
}

__device__ __forceinline__ void ml_item_A(LAS unsigned char* lds, const Ctx& X, int item, int tid) {
    asm volatile("" : "+v"(tid));
    const int lane = tid & 63, w = __builtin_amdgcn_readfirstlane(tid >> 6), fr = lane & 15, fq = lane >> 4;
    const int bh = item >> 6, n = item & 63, b = bh >> 2, h = bh & 3, tok0 = b * SEQ + n * 128;
    LAS bf16_t* Kt = (LAS bf16_t*)lds; LAS bf16_t* Vt = Kt + 96 * 136; LAS float* wg = (LAS float*)(lds + 56576);
    if (w == 0) {
        float li0, li1, bc0, bc1, blast; ml_gates(X, tok0, h, lane, li0, li1, bc0, bc1, blast);
        const float lw0 = blast - bc0 + li0, lw1 = blast - bc1 + li1, a = wave_max(fmaxf(lw0, lw1));
        wg[2 * lane] = __expf(lw0 - a); wg[2 * lane + 1] = __expf(lw1 - a);
        if (lane == 0) { X.sA[item] = a; X.sB[item] = blast; }
    }
    __syncthreads();
#pragma unroll
    for (int i = 0; i < 3; ++i) { const int pair = tid + 512 * i, part = pair % 12, c = pair / 12, token = tok0 + c, ch = h * 96 + 8 * part;
        float y[8]; conv8(X.Z + (size_t)token * ZS + ZMK + ch, n * 128 + c, X.conv_w + 384 + ch, X.conv_b + 384 + ch, y);
        const float g = wg[c];
#pragma unroll
        for (int k = 0; k < 8; ++k) y[k] *= g;
        store_col8(Kt, 136, 8 * part, c, y);
        const u32x4 v = *(const u32x4*)(X.Z + (size_t)token * ZS + ZMV + ch); unpack8(v, y);
        store_col8(Vt, 136, 8 * part, c, y); }
    for (int i = tid; i < 16 * 128; i += 512) { const int r = i >> 7, c = i & 127; Vt[(96 + r) * 136 + c] = (bf16_t)(r == 0 ? 0x3f80u : 0u); }
    __syncthreads();
    float* dst = X.st_ml + (size_t)item * ML_ST;
#pragma unroll 1
    for (int ti = w; ti < 42; ti += 8) { const int mt = ti / 6, nt = ti % 6; f32x4 acc = {0.f, 0.f, 0.f, 0.f};
#pragma unroll
        for (int ks = 0; ks < 4; ++ks) acc = mma_T(Vt, 136, mt * 16, Kt, 136, nt * 16, ks * 32, acc, fr, fq);
        const int e = mt * 16 + fr;
        if (e < 97) *(f32x4*)(dst + e * 96 + nt * 16 + 4 * fq) = acc; }
    __syncthreads();
}

__device__ __forceinline__ void pool_item(LAS unsigned char* lds, const Ctx& X, int ci, int tid) {
    asm volatile("" : "+v"(tid));
    const int lane = tid & 63, w = __builtin_amdgcn_readfirstlane(tid >> 6), fr = lane & 15, fq = lane >> 4;
    const int tok0 = ci * 128, n = ci & 63;
    LAS bf16_t* Us = (LAS bf16_t*)lds; LAS bf16_t* Ws = (LAS bf16_t*)(lds + 76032); LAS bf16_t* Pl = (LAS bf16_t*)(lds + 112896);
    for (int i = tid; i < 143 * 32; i += 512) { const int r = i >> 5, cch = i & 31; const int tseq = n * 128 - 15 + r;
        u32x4 v = {0u, 0u, 0u, 0u}; if (tseq >= 0) v = *(const u32x4*)(X.Z + (size_t)(tok0 - 15 + r) * ZS + ZPU + 8 * cch);
        *(LAS u32x4*)(Us + r * 264 + 8 * cch) = v; }
    for (int i = tid; i < 2048; i += 512) { const int r = i >> 3, cch = i & 7; *(LAS u32x4*)(Ws + r * 72 + 8 * cch) = *(const u32x4*)(X.wpT + r * 64 + 8 * cch); }
    __syncthreads();
#pragma unroll 1
    for (int g = 0; g < 4; ++g) { const int win = 2 << g;
#pragma unroll 1
        for (int i = 0; i < 2; ++i) { const int task = tid + 512 * i, oct = task & 7, c = task >> 3; float s[8] = {0.f, 0.f, 0.f, 0.f, 0.f, 0.f, 0.f, 0.f}, x[8];
            const LAS bf16_t* up = Us + (15 + c) * 264 + g * 64 + 8 * oct;
            for (int j = 0; j < win; ++j) { unpack8(*(const LAS u32x4*)(up - j * 264), x);
#pragma unroll
                for (int k = 0; k < 8; ++k) s[k] += x[k]; }
            unpack8(*(const LAS u32x4*)up, x);
            const float inv = 1.f / fminf((float)(n * 128 + c + 1), (float)win);
#pragma unroll
            for (int k = 0; k < 8; ++k) s[k] = s[k] * inv - x[k];
            *(LAS u32x4*)(Pl + c * 72 + 8 * oct) = pack8f(s); }
        __syncthreads();
        f32x4 acc[4];
#pragma unroll
        for (int nt = 0; nt < 4; ++nt) { acc[nt] = (f32x4){0.f, 0.f, 0.f, 0.f};
#pragma unroll
            for (int ks = 0; ks < 2; ++ks) acc[nt] = mma_T(Pl, 72, 16 * w, Ws + g * 64 * 72, 72, 16 * nt, 32 * ks, acc[nt], fr, fq); }
        bf16_t* zo = X.Z + (size_t)(tok0 + 16 * w + fr) * ZS + ZYP + g * 64 + 4 * fq;
#pragma unroll
        for (int nt = 0; nt < 4; ++nt) { u32x2 o; o.x = cvt_pk_bf16(acc[nt].x, acc[nt].y); o.y = cvt_pk_bf16(acc[nt].z, acc[nt].w); *(u32x2*)(zo + 16 * nt) = o; }
        __syncthreads(); }
}


__device__ __forceinline__ void t0_item(LAS unsigned char* lds, const Ctx& X, int grp, const bool xf32, const float* x0, const float* x1, const bf16_t* xb0, const bf16_t* xb1, const float* win, const float* gmix, const float* ssq, int tid) {
    asm volatile("" : "+v"(tid));
    const int lane = tid & 63, w = __builtin_amdgcn_readfirstlane(tid >> 6), ksub = lane >> 5, cl = lane & 31;
    const int col = grp * 32 + cl, src_col = col < 768 ? col : 1792 + (col - 768);
    LAS float* red = (LAS float*)lds;
    float a0 = 0.f, a1 = 0.f;
    const float* wp = win + (size_t)(128 * w + ksub) * INW + src_col;
#pragma unroll 8
    for (int i = 0; i < 64; ++i) { const int k = 128 * w + 2 * i + ksub; const float wv = wp[(size_t)(2 * i) * INW] * gmix[k];
        float xa, xc; if (xf32) { xa = x0[k]; xc = x1[k]; } else { xa = bflo((unsigned)xb0[k]); xc = bflo((unsigned)xb1[k]); } a0 += xa * wv; a1 += xc * wv; }
    red[((w * 2 + ksub) * 2 + 0) * 32 + cl] = a0; red[((w * 2 + ksub) * 2 + 1) * 32 + cl] = a1;
    __syncthreads();
    if (tid < 64) { const int bb = tid >> 5; float s = 0.f;
#pragma unroll
        for (int j = 0; j < 16; ++j) s += red[(j * 2 + bb) * 32 + cl];
        X.z0[bb * 1536 + col] = s * row_rs(ssq, bb * SEQ); }
    __syncthreads();
}

__device__ __forceinline__ void pool_half_item(LAS unsigned char* lds, const Ctx& X, int hi, int tid) {
    asm volatile("" : "+v"(tid));
    const int lane = tid & 63, w = __builtin_amdgcn_readfirstlane(tid >> 6), fr = lane & 15, fq = lane >> 4;
    const int ci = hi >> 1, hf = hi & 1, tok0 = ci * 128 + 64 * hf, tb = (ci & 63) * 128 + 64 * hf;
    LAS bf16_t* Us = (LAS bf16_t*)lds; LAS bf16_t* Ws = (LAS bf16_t*)(lds + 76032); LAS bf16_t* Pl = (LAS bf16_t*)(lds + 112896);
    for (int i = tid; i < 79 * 32; i += 512) { const int r = i >> 5, cch = i & 31; const int tseq = tb - 15 + r;
        u32x4 v = {0u, 0u, 0u, 0u}; if (tseq >= 0) v = *(const u32x4*)(X.Z + (size_t)(tok0 - 15 + r) * ZS + ZPU + 8 * cch);
        *(LAS u32x4*)(Us + r * 264 + 8 * cch) = v; }
    for (int i = tid; i < 2048; i += 512) { const int r = i >> 3, cch = i & 7; *(LAS u32x4*)(Ws + r * 72 + 8 * cch) = *(const u32x4*)(X.wpT + r * 64 + 8 * cch); }
    __syncthreads();
    const int rt = w & 3, nt0 = (w >> 2) * 2;
#pragma unroll 1
    for (int g = 0; g < 4; ++g) { const int win = 2 << g;
        { const int oct = tid & 7, c = tid >> 3; float s[8] = {0.f, 0.f, 0.f, 0.f, 0.f, 0.f, 0.f, 0.f}, x[8];
            const LAS bf16_t* up = Us + (15 + c) * 264 + g * 64 + 8 * oct;
            for (int j = 0; j < win; ++j) { unpack8(*(const LAS u32x4*)(up - j * 264), x);
#pragma unroll
                for (int k = 0; k < 8; ++k) s[k] += x[k]; }
            unpack8(*(const LAS u32x4*)up, x);
            const float inv = 1.f / fminf((float)(tb + c + 1), (float)win);
#pragma unroll
            for (int k = 0; k < 8; ++k) s[k] = s[k] * inv - x[k];
            *(LAS u32x4*)(Pl + c * 72 + 8 * oct) = pack8f(s); }
        __syncthreads();
        f32x4 acc[2];
#pragma unroll
        for (int i = 0; i < 2; ++i) { acc[i] = (f32x4){0.f, 0.f, 0.f, 0.f};
#pragma unroll
            for (int ks = 0; ks < 2; ++ks) acc[i] = mma_T(Pl, 72, 16 * rt, Ws + g * 64 * 72, 72, 16 * (nt0 + i), 32 * ks, acc[i], fr, fq); }
        bf16_t* zo = X.Z + (size_t)(tok0 + 16 * rt + fr) * ZS + ZYP + g * 64 + 4 * fq;
#pragma unroll
        for (int i = 0; i < 2; ++i) { u32x2 o; o.x = cvt_pk_bf16(acc[i].x, acc[i].y); o.y = cvt_pk_bf16(acc[i].z, acc[i].w); *(u32x2*)(zo + 16 * (nt0 + i)) = o; }
        __syncthreads(); }
}

__device__ __forceinline__ void scan_phase(const Ctx& X, int gtid, int nthreads) {
    asm volatile("" : "+v"(gtid));
    for (int idx = gtid; idx < 49152 + 8 * ML_ST; idx += nthreads) {
        if (idx < 49152) {
            const int bh = idx >> 12, el = idx & 4095, h = bh % 6; const float cd = exp2f(128.f * l2gamma(h));
            float* p = X.st_ret + (size_t)bh * 64 * 4096 + el; float st = 0.f;
#pragma unroll 1
            for (int n0 = 0; n0 < 64; n0 += 32) { float kv[32];
#pragma unroll
                for (int j = 0; j < 32; ++j) kv[j] = p[(size_t)(n0 + j) * 4096];
#pragma unroll
                for (int j = 0; j < 32; ++j) { p[(size_t)(n0 + j) * 4096] = st; st = cd * st + kv[j]; } }
        } else {
            const int j0 = idx - 49152, bh = j0 / ML_ST, el = j0 % ML_ST;
            float* p = X.st_ml + (size_t)bh * 64 * ML_ST + el; float st = 0.f, m = 0.f;
#pragma unroll 1
            for (int n0 = 0; n0 < 64; n0 += 32) { float kv[32];
#pragma unroll
                for (int j = 0; j < 32; ++j) kv[j] = p[(size_t)(n0 + j) * ML_ST];
#pragma unroll
                for (int j = 0; j < 32; ++j) { const int item = bh * 64 + n0 + j; const float a = X.sA[item], bl = X.sB[item];
                    p[(size_t)(n0 + j) * ML_ST] = st; if (el == 0) X.sM[item] = m;
                    const float mn = fmaxf(bl + m, a), so = __expf(bl + m - mn), sw = __expf(a - mn);
                    st = so * st + sw * kv[j]; m = mn; } }
        }
    }
}

__device__ __forceinline__ void ret_item_C(LAS unsigned char* lds, const Ctx& X, int item, int tid) {
    asm volatile("" : "+v"(tid));
    const int lane = tid & 63, w = __builtin_amdgcn_readfirstlane(tid >> 6), fr = lane & 15, fq = lane >> 4;
    const int bh = item >> 6, n = item & 63, b = bh / 6, h = bh % 6, tok0 = b * SEQ + n * 128;
    const float l2g = l2gamma(h);
    LAS bf16_t* Qs = (LAS bf16_t*)lds; LAS bf16_t* Ks = Qs + 128 * 72; LAS bf16_t* Vt = Ks + 128 * 72; LAS bf16_t* Ps = Vt + 64 * 136; LAS bf16_t* Rt = Ps + 128 * 136;
    bf16_t* gp = X.Z + (size_t)(tok0 + 16 * w + fr) * ZS + ZG + h * 64 + 4 * fq;
    u32x2 gpre[4];
#pragma unroll
    for (int nt = 0; nt < 4; ++nt) gpre[nt] = *(const u32x2*)(gp + 16 * nt);
    {
        const int c = tid >> 2, p = tid & 3, token = tok0 + c;
        const bf16_t* zr = X.Z + (size_t)token * ZS + h * 64;
        const u32x4 q1 = *(const u32x4*)(zr + ZQ + 8 * p), q2 = *(const u32x4*)(zr + ZQ + 32 + 8 * p);
        const u32x4 k1 = *(const u32x4*)(zr + ZK + 8 * p), k2 = *(const u32x4*)(zr + ZK + 32 + 8 * p);
        const u32x4 v1 = *(const u32x4*)(zr + ZV + 16 * p), v2 = *(const u32x4*)(zr + ZV + 16 * p + 8);
        const float* rsrc = X.st_ret + (size_t)item * 4096 + (tid >> 3) * 64 + (tid & 7) * 8;
        const f32x4 r0 = *(const f32x4*)rsrc, r1 = *(const f32x4*)(rsrc + 4);
        float sn[8], cs[8]; rope8((float)X.pos[token], p, sn, cs);
        float a[8], bq[8], o1[8], o2[8];
        unpack8(q1, a); unpack8(q2, bq);
#pragma unroll
        for (int i = 0; i < 8; ++i) { o1[i] = a[i] * cs[i] - bq[i] * sn[i]; o2[i] = a[i] * sn[i] + bq[i] * cs[i]; }
        *(LAS u32x4*)(Qs + c * 72 + 8 * p) = pack8f(o1); *(LAS u32x4*)(Qs + c * 72 + 32 + 8 * p) = pack8f(o2);
        unpack8(k1, a); unpack8(k2, bq);
#pragma unroll
        for (int i = 0; i < 8; ++i) { o1[i] = (a[i] * cs[i] - bq[i] * sn[i]) * 0.125f; o2[i] = (a[i] * sn[i] + bq[i] * cs[i]) * 0.125f; }
        *(LAS u32x4*)(Ks + c * 72 + 8 * p) = pack8f(o1); *(LAS u32x4*)(Ks + c * 72 + 32 + 8 * p) = pack8f(o2);
        unpack8(v1, a); unpack8(v2, bq);
        store_col8(Vt, 136, 16 * p, c, a); store_col8(Vt, 136, 16 * p + 8, c, bq);
        *(LAS u32x4*)(Rt + (tid >> 3) * 72 + (tid & 7) * 8) = pack8(r0, r1);
    }
    __syncthreads();
    const int nks = (w >> 1) + 1;
    const int crow = 16 * w + fr;
#pragma unroll
    for (int nt = 0; nt < 8; ++nt) {
        if (nt < 2 * nks) {
            f32x4 s = {0.f, 0.f, 0.f, 0.f};
            if (nt <= w) {
#pragma unroll
                for (int ks = 0; ks < 2; ++ks) s = mma_T(Qs, 72, 16 * w, Ks, 72, 16 * nt, 32 * ks, s, fr, fq);
                const int s0 = 16 * nt + 4 * fq; float pv[4] = {s.x, s.y, s.z, s.w};
#pragma unroll
                for (int j = 0; j < 4; ++j) { const int d = crow - (s0 + j); pv[j] = d >= 0 ? pv[j] * exp2f((float)d * l2g) : 0.f; }
                if (n == 0 && w == 0 && nt == 0) {
                    const float* zq = X.z0 + b * 1536 + h * 64 + lane;
                    const float p00 = wave_sum(zq[0] * zq[384]) * 0.125f;
                    if (lane == 0) pv[0] = p00; }
                s = (f32x4){pv[0], pv[1], pv[2], pv[3]};
            }
            u32x2 o; o.x = cvt_pk_bf16(s.x, s.y); o.y = cvt_pk_bf16(s.z, s.w);
            *(LAS u32x2*)(Ps + crow * 136 + 16 * nt + 4 * fq) = o;
        }
    }
    __syncthreads();
    f32x4 y[4];
    const float xi = exp2f((float)(crow + 1) * l2g);
#pragma unroll
    for (int nt = 0; nt < 4; ++nt) { y[nt] = (f32x4){0.f, 0.f, 0.f, 0.f};
#pragma unroll
        for (int ks = 0; ks < 2; ++ks) y[nt] = mma_T(Qs, 72, 16 * w, Rt, 72, 16 * nt, 32 * ks, y[nt], fr, fq);
        y[nt] = y[nt] * xi; }
#pragma unroll
    for (int ks = 0; ks < 4; ++ks) if (ks < nks) {
#pragma unroll
        for (int nt = 0; nt < 4; ++nt) y[nt] = mma_T(Ps, 136, 16 * w, Vt, 136, 16 * nt, 32 * ks, y[nt], fr, fq); }
    float sum = 0.f;
#pragma unroll
    for (int nt = 0; nt < 4; ++nt) sum += (y[nt].x + y[nt].y) + (y[nt].z + y[nt].w);
    sum += __shfl_xor(sum, 16); sum += __shfl_xor(sum, 32);
    const float mu = sum * (1.f / 64.f); float var = 0.f;
#pragma unroll
    for (int nt = 0; nt < 4; ++nt) { y[nt] = y[nt] - mu; var += sumsq4(y[nt]); }
    var += __shfl_xor(var, 16); var += __shfl_xor(var, 32);
    const float rstd = rsqrtf(var * (1.f / 64.f) + 1e-6f);
    const float* gn = X.ret_gn + h * 64 + 4 * fq;
#pragma unroll
    for (int nt = 0; nt < 4; ++nt) { const u32x2 gw = gpre[nt]; const f32x4 gg = *(const f32x4*)(gn + 16 * nt);
        const float g0 = bflo(gw.x), g1 = bfhi(gw.x), g2 = bflo(gw.y), g3 = bfhi(gw.y);
        const f32x4 o = y[nt] * rstd * gg;
        u32x2 ov; ov.x = cvt_pk_bf16(g0 * fsigmoid(g0) * o.x, g1 * fsigmoid(g1) * o.y); ov.y = cvt_pk_bf16(g2 * fsigmoid(g2) * o.z, g3 * fsigmoid(g3) * o.w);
        *(u32x2*)(gp + 16 * nt) = ov; }
    __syncthreads();
}

__device__ __forceinline__ void ml_item_C(LAS unsigned char* lds, const Ctx& X, int item, int tid) {
    asm volatile("" : "+v"(tid));
    const int lane = tid & 63, w = __builtin_amdgcn_readfirstlane(tid >> 6), fr = lane & 15, fq = lane >> 4;
    const int bh = item >> 6, n = item & 63, b = bh >> 2, h = bh & 3, tok0 = b * SEQ + n * 128;
    LAS bf16_t* Qs = (LAS bf16_t*)lds; LAS bf16_t* Ks = Qs + 128 * 104; LAS bf16_t* Vt = Ks + 128 * 104; LAS bf16_t* Ps = Vt + 112 * 136; LAS bf16_t* Ct = Ps + 128 * 136;
    LAS float* uS = (LAS float*)(lds + 141824); LAS float* MS = uS + 128; LAS float* inS = MS + 128; LAS float* emS = inS + 128;
    bf16_t* op = X.Z + (size_t)(tok0 + 16 * w + fr) * ZS + ZMO + h * 96 + 4 * fq;
    u32x2 opre[6];
#pragma unroll
    for (int nt = 0; nt < 6; ++nt) opre[nt] = *(const u32x2*)(op + 16 * nt);
    if (w == 0) {
        float li0, li1, bc0, bc1, blast; ml_gates(X, tok0, h, lane, li0, li1, bc0, bc1, blast);
        const float mprev = X.sM[item];
        const float u0 = li0 - bc0, u1 = li1 - bc1;
        const float incl = wave_scan_max(fmaxf(u0, u1), lane);
        float excl = __shfl_up(incl, 1); if (lane == 0) excl = -INFINITY;
        const float gm0 = fmaxf(excl, u0), gm1 = fmaxf(gm0, u1);
        const float M0 = fmaxf(mprev, gm0), M1 = fmaxf(mprev, gm1);
        uS[2 * lane] = u0; uS[2 * lane + 1] = u1; MS[2 * lane] = M0; MS[2 * lane + 1] = M1;
        inS[2 * lane] = __expf(mprev - M0); inS[2 * lane + 1] = __expf(mprev - M1);
        emS[2 * lane] = __expf(-(bc0 + M0)); emS[2 * lane + 1] = __expf(-(bc1 + M1));
    }
#pragma unroll
    for (int i = 0; i < 3; ++i) { const int pair = tid + 512 * i, part = pair % 12, c = pair / 12, token = tok0 + c, ch = h * 96 + 8 * part;
        float y[8]; conv8(X.Z + (size_t)token * ZS + ZMQ + ch, n * 128 + c, X.conv_w + ch, X.conv_b + ch, y);
#pragma unroll
        for (int k = 0; k < 8; ++k) y[k] *= 0.10206207261596577f;
        *(LAS u32x4*)(Qs + c * 104 + 8 * part) = pack8f(y);
        conv8(X.Z + (size_t)token * ZS + ZMK + ch, n * 128 + c, X.conv_w + 384 + ch, X.conv_b + 384 + ch, y);
        *(LAS u32x4*)(Ks + c * 104 + 8 * part) = pack8f(y);
        const u32x4 v = *(const u32x4*)(X.Z + (size_t)token * ZS + ZMV + ch); unpack8(v, y);
        store_col8(Vt, 136, 8 * part, c, y); }
    for (int i = tid; i < 16 * 128; i += 512) { const int r = i >> 7, c = i & 127; Vt[(96 + r) * 136 + c] = (bf16_t)(r == 0 ? 0x3f80u : 0u); }
    { const float* src = X.st_ml + (size_t)item * ML_ST;
      for (int i = tid; i < 97 * 12; i += 512) { const int e = i / 12, c8 = i % 12; const f32x4 a = *(const f32x4*)(src + e * 96 + 8 * c8), bq = *(const f32x4*)(src + e * 96 + 8 * c8 + 4);
          *(LAS u32x4*)(Ct + e * 104 + 8 * c8) = pack8(a, bq); }
      for (int i = tid; i < 15 * 12; i += 512) { const int e = 97 + i / 12, c8 = i % 12; *(LAS u32x4*)(Ct + e * 104 + 8 * c8) = (u32x4){0u, 0u, 0u, 0u}; } }
    __syncthreads();
    const int nks = (w >> 1) + 1;
    const int crow = 16 * w + fr;
    const float Mc = MS[crow];
#pragma unroll
    for (int nt = 0; nt < 8; ++nt) {
        if (nt < 2 * nks) {
            f32x4 s = {0.f, 0.f, 0.f, 0.f};
            if (nt <= w) {
#pragma unroll
                for (int ks = 0; ks < 3; ++ks) s = mma_T(Qs, 104, 16 * w, Ks, 104, 16 * nt, 32 * ks, s, fr, fq);
                const int s0 = 16 * nt + 4 * fq; float pv[4] = {s.x, s.y, s.z, s.w};
                const f32x4 us = *(const LAS f32x4*)(uS + s0); const float uu[4] = {us.x, us.y, us.z, us.w};
#pragma unroll
                for (int j = 0; j < 4; ++j) pv[j] = (s0 + j <= crow) ? pv[j] * __expf(uu[j] - Mc) : 0.f;
                if (n == 0 && w == 0 && nt == 0) {
                    const float* zq = X.z0 + b * 1536 + 768 + h * 96; const float* cwq = X.conv_w + 3 * 768 + h * 96; const float* cbq = X.conv_b + h * 96;
                    float part = 0.f;
#pragma unroll
                    for (int rep = 0; rep < 2; ++rep) { const int d = lane + 64 * rep;
                        if (d < 96) { float qv = cbq[d] + cwq[d] * zq[d], kv = cbq[384 + d] + cwq[384 + d] * zq[384 + d];
                            qv = qv * fsigmoid(qv) * 0.10206207261596577f; kv = kv * fsigmoid(kv); part += qv * kv; } }
                    const float s00 = wave_sum(part) * __expf(uS[0] - MS[0]);
                    if (lane == 0) pv[0] = s00; }
                s = (f32x4){pv[0], pv[1], pv[2], pv[3]};
            }
            u32x2 o; o.x = cvt_pk_bf16(s.x, s.y); o.y = cvt_pk_bf16(s.z, s.w);
            *(LAS u32x2*)(Ps + crow * 136 + 16 * nt + 4 * fq) = o;
        }
    }
    __syncthreads();
    f32x4 y[7];
    const float inter = inS[crow];
#pragma unroll
    for (int nt = 0; nt < 7; ++nt) { y[nt] = (f32x4){0.f, 0.f, 0.f, 0.f};
#pragma unroll
        for (int ks = 0; ks < 3; ++ks) y[nt] = mma_T(Qs, 104, 16 * w, Ct, 104, 16 * nt, 32 * ks, y[nt], fr, fq);
        y[nt] = y[nt] * inter; }
#pragma unroll
    for (int ks = 0; ks < 4; ++ks) if (ks < nks) {
#pragma unroll
        for (int nt = 0; nt < 7; ++nt) y[nt] = mma_T(Ps, 136, 16 * w, Vt, 136, 16 * nt, 32 * ks, y[nt], fr, fq); }
    const float den_raw = __shfl(y[6].x, fr);
    const float rden = 1.f / fmaxf(fabsf(den_raw), emS[crow]);
    float sum = 0.f;
#pragma unroll
    for (int nt = 0; nt < 6; ++nt) { y[nt] = y[nt] * rden; sum += (y[nt].x + y[nt].y) + (y[nt].z + y[nt].w); }
    sum += __shfl_xor(sum, 16); sum += __shfl_xor(sum, 32);
    const float mu = sum * (1.f / 96.f); float var = 0.f;
#pragma unroll
    for (int nt = 0; nt < 6; ++nt) { y[nt] = y[nt] - mu; var += sumsq4(y[nt]); }
    var += __shfl_xor(var, 16); var += __shfl_xor(var, 32);
    const float rstd = rsqrtf(var * (1.f / 96.f) + 1e-6f);
    const float* gn = X.ml_gn + h * 96 + 4 * fq;
#pragma unroll
    for (int nt = 0; nt < 6; ++nt) { const u32x2 ow = opre[nt]; const f32x4 gg = *(const f32x4*)(gn + 16 * nt);
        const f32x4 o = y[nt] * rstd * gg;
        u32x2 ov; ov.x = cvt_pk_bf16(fsigmoid(bflo(ow.x)) * o.x, fsigmoid(bfhi(ow.x)) * o.y); ov.y = cvt_pk_bf16(fsigmoid(bflo(ow.y)) * o.z, fsigmoid(bfhi(ow.y)) * o.w);
        *(u32x2*)(op + 16 * nt) = ov; }
    __syncthreads();
}

__device__ __forceinline__ void transpose_item(const float* W, int ldw, int src0, int nvalid, const float* gain, bf16_t* Bt, int K, int r0, int k0, LAS float* scr, int lane) {
    const int c4 = (lane & 15) * 4, kq = lane >> 4;
    f32x4 v[16];
#pragma unroll
    for (int i = 0; i < 16; ++i) { const int kk = 4 * i + kq; v[i] = (f32x4){0.f, 0.f, 0.f, 0.f};
        if (c4 < nvalid) v[i] = *(const f32x4*)(W + (size_t)(k0 + kk) * ldw + src0 + c4);
        if (gain) v[i] = v[i] * gain[k0 + kk]; }
#pragma unroll
    for (int i = 0; i < 16; ++i) { LAS float* d = scr + (4 * i + kq) * 65 + c4; d[0] = v[i].x; d[1] = v[i].y; d[2] = v[i].z; d[3] = v[i].w; }
    asm volatile("s_waitcnt lgkmcnt(0)" ::: "memory");
    const int c = lane & 7;
#pragma unroll
    for (int j = 0; j < 8; ++j) { const int nn = (lane >> 3) + 8 * j; const LAS float* s = scr + (8 * c) * 65 + nn;
        u32x4 o; o.x = cvt_pk_bf16(s[0 * 65], s[1 * 65]); o.y = cvt_pk_bf16(s[2 * 65], s[3 * 65]); o.z = cvt_pk_bf16(s[4 * 65], s[5 * 65]); o.w = cvt_pk_bf16(s[6 * 65], s[7 * 65]);
        *(u32x4*)(Bt + (size_t)(r0 + nn) * K + k0 + 8 * c) = o; }
    asm volatile("s_waitcnt lgkmcnt(0)" ::: "memory");
}

struct Params { const float* in[21]; float* out; unsigned char* ws; int ph_lo, ph_hi; };
template <class Tp> __device__ __forceinline__ Tp* launder(Tp* p) { asm volatile("" : "+s"(p)); return p; }
typedef const __attribute__((address_space(4))) Params* KArgs;
__device__ __forceinline__ KArgs kargs() { KArgs p = (KArgs)__builtin_amdgcn_kernarg_segment_ptr(); asm volatile("" : "+s"(p)); return p; }

__device__ __forceinline__ void convert_weights(const int l, const int i0, const int i1, const int gw, const int NGW, LAS float* scr, const int lane) {
    KArgs P = kargs(); unsigned char* wl = P->ws + (size_t)l * WL;
    for (int it = i0 + gw; it < i1; it += NGW) {
        int r = it;
        if (r < 896) { const int nb = r % 56, kb = r / 56, r0 = nb * 64;
            const int src0 = r0 < 1536 ? r0 : r0 < 1920 ? r0 + 1408 : r0 < 3072 ? r0 - 128 : r0 < 3328 ? r0 - 1536 : r0;
            const int nvalid = r0 < 3328 ? 64 : (r0 == 3328 ? 8 : 0);
            transpose_item(P->in[4] + (size_t)l * DM * INW, INW, src0 < INW ? src0 : 0, nvalid, P->in[3] + l * DM, (bf16_t*)(wl + O_WIN), DM, r0, kb * 64, scr, lane); continue; }
        r -= 896;
        if (r < 256) { const int nb = r % 16, kb = r / 16; transpose_item(P->in[13] + (size_t)l * DM * DM, DM, nb * 64, 64, nullptr, (bf16_t*)(wl + O_WOUT), DM, nb * 64, kb * 64, scr, lane); continue; }
        r -= 256;
        if (r < 1408) { const int nb = r % 88, kb = r / 88, r0 = nb * 64, tile = r0 >> 8, cc0 = r0 & 255, j0 = 128 * tile + (cc0 & 127), src0 = cc0 < 128 ? j0 : DFF + j0;
            transpose_item(P->in[15] + (size_t)l * DM * 2 * DFF, 2 * DFF, src0, 64, P->in[14] + l * DM, (bf16_t*)(wl + O_WGU), DM, r0, kb * 64, scr, lane); continue; }
        r -= 1408;
        if (r < 704) { const int nb = r % 16, kb = r / 16; transpose_item(P->in[16] + (size_t)l * DFF * DM, DM, nb * 64, 64, nullptr, (bf16_t*)(wl + O_WD), DFF, nb * 64, kb * 64, scr, lane); continue; }
        r -= 704;
        if (r < 256) { const int nb = r % 16, kb = r / 16; transpose_item(P->in[18] + (size_t)l * DM * DM, DM, nb * 64, 64, P->in[17] + l * DM, (bf16_t*)(wl + O_WPG), DM, nb * 64, kb * 64, scr, lane); continue; }
        r -= 256;
        { const int nb = r % 16, kb = r / 16; transpose_item(P->in[19] + (size_t)l * PLE * DM, DM, nb * 64, 64, nullptr, (bf16_t*)(wl + O_WPP), PLE, nb * 64, kb * 64, scr, lane); }
    }
}

__device__ __forceinline__ void convert_p(const int l, const int gw, const int NGW, const int lane) {
    KArgs P = kargs(); const float* src = P->in[1] + (size_t)l * T * PLE; bf16_t* dst = (bf16_t*)(P->ws + WS_PB) + (size_t)l * T * PLE;
    for (int m0 = 4 * gw; m0 < T * PLE / 1024; m0 += 4 * NGW) {
        f32x4 v[4][4];
#pragma unroll
        for (int r = 0; r < 4; ++r) { const f32x4* xr = (const f32x4*)(src + (size_t)(m0 + r) * 1024) + lane;
#pragma unroll
            for (int j = 0; j < 4; ++j) v[r][j] = xr[64 * j]; }
#pragma unroll
        for (int r = 0; r < 4; ++r) { u32x2* o = (u32x2*)(dst + (size_t)(m0 + r) * 1024) + lane;
#pragma unroll
            for (int j = 0; j < 4; ++j) { u32x2 w; w.x = cvt_pk_bf16(v[r][j].x, v[r][j].y); w.y = cvt_pk_bf16(v[r][j].z, v[r][j].w); o[64 * j] = w; } }
    }
}

__device__ __forceinline__ Ctx make_ctx(int l) {
    KArgs P = kargs(); unsigned char* ws = P->ws;
    Ctx X;
    X.pos = (const int*)P->in[2]; X.ret_gn = P->in[5] + l * 384; X.conv_w = P->in[8] + l * 3072; X.conv_b = P->in[9] + l * 768; X.b_i = P->in[10] + l * 4; X.b_f = P->in[11] + l * 4; X.ml_gn = P->in[12] + l * 384;
    X.Z = (bf16_t*)(ws + WS_Z); X.gates = (const float*)(ws + WS_GATES); X.st_ret = (float*)(ws + WS_ST); X.st_ml = (float*)(ws + WS_ST + ST_ML_OFF);
    X.sA = (float*)(ws + WS_SC); X.sB = X.sA + 512; X.sM = X.sA + 1024; X.z0 = (float*)(ws + WS_Z0); X.wpT = (const bf16_t*)(ws + (size_t)l * WL + O_WPT);
    return X;
}

__device__ __forceinline__ void run_layer(const int l, LAS unsigned char* lds, const XcdBarrier& xbar, const int G, const int ph_lo, const int ph_hi) {
    int tid = threadIdx.x; const int pb = 1 + 8 * l;
        if (IN_PH(pb + 0)) {
        { KArgs P = kargs(); unsigned char* ws = P->ws;
          pg8::Gemm g{(const bf16_t*)(ws + WS_XB0), (const bf16_t*)(ws + (size_t)l * WL + O_WIN), T, 3584, DM, DM, (const float*)(ws + WS_SSQ0)}; pg8::StaticOrder S; S.init(T, 3584, G, (int)blockIdx.x);
          EpiZ E{(bf16_t*)(ws + WS_Z), (float*)(ws + WS_GATES), (const float*)(ws + WS_SSQ0)}; pg8::gemm_phase<EpiZ, true>(lds, g, S, E);
          if (2 * (S.nwg % G) == G) {
              if ((int)blockIdx.x >= S.nwg % G) {
                  int t_ = threadIdx.x; asm volatile("" : "+v"(t_)); const int w_ = __builtin_amdgcn_readfirstlane(t_ >> 6), rem_ = S.nwg % G;
                  convert_p(l, ((int)blockIdx.x - rem_) * 8 + w_, (G - rem_) * 8, t_ & 63);
                  if (l == 0) convert_weights(1, 0, 1600, ((int)blockIdx.x - rem_) * 8 + w_, (G - rem_) * 8, (LAS float*)(lds + w_ * 16640), t_ & 63);
                  if (G - rem_ >= 48) { __syncthreads();
                      if ((int)blockIdx.x - rem_ < 48) { const Ctx X0 = make_ctx(l); const float* xs = P->in[0]; const bf16_t* xbs = (const bf16_t*)(ws + WS_XB0);
                          t0_item(lds, X0, (int)blockIdx.x - rem_, l == 0, xs, xs + (size_t)SEQ * DM, xbs, xbs + (size_t)SEQ * DM, P->in[4] + (size_t)l * DM * INW, P->in[3] + l * DM, (const float*)(ws + WS_SSQ0), t_); } } }
          } else { int t_ = threadIdx.x; asm volatile("" : "+v"(t_)); const int w_ = __builtin_amdgcn_readfirstlane(t_ >> 6);
              convert_p(l, (int)blockIdx.x * 8 + w_, G * 8, t_ & 63);
              if (l == 0) convert_weights(1, 0, 1600, (int)blockIdx.x * 8 + w_, G * 8, (LAS float*)(lds + w_ * 16640), t_ & 63); } }
        }
        SEAM(pb + 0);
        if (IN_PH(pb + 1)) {
        { const Ctx X = make_ctx(l);
          const bool t0_in_shadow = (2 * (((T / 256) * 14) % G) == G) && (G - ((T / 256) * 14) % G >= 48);
          for (int it = blockIdx.x; it < (t0_in_shadow ? 1536 : 1584); it += G) {
              if (it < 512) ml_item_A(lds, X, it, tid); else if (it < 1280) ret_item_A(lds, X, it - 512, tid); else if (it < 1536) pool_half_item(lds, X, it - 1280, tid);
              else { KArgs P = kargs(); const float* xs = P->in[0]; const bf16_t* xbs = (const bf16_t*)(P->ws + WS_XB0);
                     t0_item(lds, X, it - 1536, l == 0, xs, xs + (size_t)SEQ * DM, xbs, xbs + (size_t)SEQ * DM, P->in[4] + (size_t)l * DM * INW, P->in[3] + l * DM, (const float*)(P->ws + WS_SSQ0), tid); }
          } }
        }
        SEAM(pb + 1);
        if (IN_PH(pb + 2)) {
        { const Ctx X = make_ctx(l); scan_phase(X, blockIdx.x * 512 + tid, G * 512); }
        }
        SEAM(pb + 2);
        if (IN_PH(pb + 3)) {
        { const Ctx X = make_ctx(l);
          for (int it = blockIdx.x; it < 1280; it += G) {
              if (it < 512) ml_item_C(lds, X, it, tid); else ret_item_C(lds, X, it - 512, tid);
          } }
        }
        SEAM(pb + 3);
        if (IN_PH(pb + 4)) {
        { KArgs P = kargs(); unsigned char* ws = P->ws;
          pg8::Gemm g{(const bf16_t*)(ws + WS_Z) + ZG, (const bf16_t*)(ws + (size_t)l * WL + O_WOUT), T, DM, DM, ZS, nullptr}; pg8::StaticOrder S; S.init(T, DM, G, (int)blockIdx.x);
          EpiRes E{(const bf16_t*)(ws + WS_XB0), (bf16_t*)(ws + WS_XB0), (float*)(ws + WS_SSQ0)}; pg8::gemm_phase<EpiRes, true>(lds, g, S, E); }
        }
        SEAM(pb + 4);
        if (IN_PH(pb + 5)) {
        { KArgs P = kargs(); unsigned char* ws = P->ws;
          pg8::Gemm g{(const bf16_t*)(ws + WS_XB0), (const bf16_t*)(ws + (size_t)l * WL + O_WGU), T, 2 * DFF, DM, DM, (const float*)(ws + WS_SSQ0)}; pg8::StaticOrder S; S.init(T, 2 * DFF, G, (int)blockIdx.x);
          EpiSwiGLU E{(bf16_t*)(ws + WS_Z), (const float*)(ws + WS_SSQ0)}; pg8::gemm_phase<EpiSwiGLU, true>(lds, g, S, E);
          if (l == 0) { int t_ = threadIdx.x; asm volatile("" : "+v"(t_)); const int w_ = __builtin_amdgcn_readfirstlane(t_ >> 6), rem_ = S.nwg % G;
              if (2 * rem_ == G) { if ((int)blockIdx.x >= rem_) convert_weights(1, 1600, 3584, ((int)blockIdx.x - rem_) * 8 + w_, (G - rem_) * 8, (LAS float*)(lds + w_ * 16640), t_ & 63); }
              else convert_weights(1, 1600, 3584, (int)blockIdx.x * 8 + w_, G * 8, (LAS float*)(lds + w_ * 16640), t_ & 63); } }
        }
        SEAM(pb + 5);
        if (IN_PH(pb + 6)) {
        { KArgs P = kargs(); unsigned char* ws = P->ws;
          pg8::Gemm g{(const bf16_t*)(ws + WS_Z), (const bf16_t*)(ws + (size_t)l * WL + O_WD), T, DM, DFF, DFF, nullptr}; pg8::StaticOrder S; S.init(T, DM, G, (int)blockIdx.x);
          EpiRes E{(const bf16_t*)(ws + WS_XB0), (bf16_t*)(ws + WS_ST), (float*)(ws + WS_SSQ1)}; pg8::gemm_phase<EpiRes, true>(lds, g, S, E); }
        }
        SEAM(pb + 6);
        if (IN_PH(pb + 7)) {
        { KArgs P = kargs(); unsigned char* ws = P->ws;
          pg8::Gemm g{(const bf16_t*)(ws + WS_PB) + (size_t)l * T * PLE, (const bf16_t*)(ws + (size_t)l * WL + O_WPP), T, DM, PLE, PLE, nullptr}; pg8::StaticOrder S; S.init(T, DM, G, (int)blockIdx.x);
          EpiProj E{(bf16_t*)(ws + WS_Z)}; pg8::gemm_phase<EpiProj, true>(lds, g, S, E); }
        { KArgs P = kargs(); unsigned char* ws = P->ws;
          pg8::Gemm g{(const bf16_t*)(ws + WS_ST), (const bf16_t*)(ws + (size_t)l * WL + O_WPG), T, DM, DM, DM, (const float*)(ws + WS_SSQ1)}; pg8::StaticOrder S; S.init(T, DM, G, (int)blockIdx.x);
          EpiPle E{(const bf16_t*)(ws + WS_ST), (const bf16_t*)(ws + WS_Z), (bf16_t*)(ws + WS_XB0), (const float*)(ws + WS_SSQ1), (float*)(ws + WS_SSQ0)}; pg8::gemm_phase<EpiPle, true>(lds, g, S, E); }
        }
        SEAM(pb + 7);
    }

__global__ void __launch_bounds__(512, 2) fwd(Params Pun) {
    extern __shared__ __attribute__((aligned(16))) unsigned char lds_raw[];
    LAS unsigned char* lds = (LAS unsigned char*)lds_raw;
    cg::grid_group grid = cg::this_grid();
    const int tid = threadIdx.x, lane = tid & 63, wave = __builtin_amdgcn_readfirstlane(tid >> 6);
    const int G = gridDim.x;

    const int ph_lo = kargs()->ph_lo, ph_hi = kargs()->ph_hi;
    volatile LAS unsigned* bst = (volatile LAS unsigned*)(lds + LDS_BYTES - 16);
    if (tid == 0) { bst[0] = 0u; bst[1] = 0u; }
    __syncthreads();
    const XcdBarrier xbar = xcd_barrier_post((unsigned*)(kargs()->ws + WS_BAR), bst);
    if (IN_PH(0)) {
        KArgs P = kargs(); unsigned char* ws = P->ws;
        const int gw = blockIdx.x * 8 + wave, NGW = G * 8;
        LAS float* scr = (LAS float*)(lds + wave * 16640);
        convert_weights(0, 0, 3584, gw, NGW, scr, lane);
        bf16_t* XB0 = (bf16_t*)(ws + WS_XB0); float* SSQ0 = (float*)(ws + WS_SSQ0);
        for (int m0 = 4 * gw; m0 < T; m0 += 4 * NGW) {
            f32x4 v[4][4]; float s[4];
#pragma unroll
            for (int r = 0; r < 4; ++r) { const f32x4* xr = (const f32x4*)(P->in[0] + (size_t)(m0 + r) * DM) + lane;
#pragma unroll
                for (int j = 0; j < 4; ++j) v[r][j] = xr[64 * j]; }
#pragma unroll
            for (int r = 0; r < 4; ++r) { s[r] = 0.f;
#pragma unroll
                for (int j = 0; j < 4; ++j) s[r] += sumsq4(v[r][j]);
                s[r] = wave_sum(s[r]);
                u32x2* o = (u32x2*)(XB0 + (size_t)(m0 + r) * DM) + lane;
#pragma unroll
                for (int j = 0; j < 4; ++j) { u32x2 w; w.x = cvt_pk_bf16(v[r][j].x, v[r][j].y); w.y = cvt_pk_bf16(v[r][j].z, v[r][j].w); o[64 * j] = w; }
                if (lane < 16) SSQ0[(size_t)(m0 + r) * 16 + lane] = lane == 0 ? s[r] : 0.f; }
        }
        for (int o = blockIdx.x * 512 + tid; o < 2 * 16384; o += G * 512) {
            const int l = o >> 14, rem = o & 16383, g = rem >> 12, d = (rem >> 6) & 63, c = rem & 63;
            const float v = P->in[6][(size_t)l * 16384 + g * 4096 + c * 64 + d] * P->in[7][l * 256 + g * 64 + d];
            ((bf16_t*)(ws + (size_t)l * WL + O_WPT))[rem] = (bf16_t)(cvt_pk_bf16(v, v) & 0xffffu);
        }
    }
    if (ph_hi == 0x7fffffff) GRID_SYNC();
    SEAM(0);
    run_layer(0, lds, xbar, G, ph_lo, ph_hi);
    run_layer(1, lds, xbar, G, ph_lo, ph_hi);
    if (IN_PH(17)) { KArgs P = kargs(); float* outp = P->out; const bf16_t* xbf = (const bf16_t*)(P->ws + WS_XB0); const float* sq = (const float*)(P->ws + WS_SSQ0);
      const int gw = blockIdx.x * 8 + wave, NGW = G * 8;
      for (int m = gw; m < T; m += NGW) {
        const float rs = row_rs(sq, m);
        const u32x4* xr = (const u32x4*)(xbf + (size_t)m * DM) + lane;
        const f32x4* gp = (const f32x4*)(P->in[20]); f32x4* o = (f32x4*)(outp + (size_t)m * DM);
#pragma unroll
        for (int j = 0; j < 2; ++j) { const u32x4 w = xr[64 * j]; const int c4 = 2 * (lane + 64 * j);
            const f32x4 a = {bflo(w.x), bfhi(w.x), bflo(w.y), bfhi(w.y)}, b = {bflo(w.z), bfhi(w.z), bflo(w.w), bfhi(w.w)};
            o[c4] = a * rs * gp[c4]; o[c4 + 1] = b * rs * gp[c4 + 1]; }
      } }
}

extern "C" void kernel_launch(void* const* d_in, const int* in_sizes, int n_in, void* d_out, int out_size, void* d_ws, size_t ws_size, hipStream_t stream) {
    static int grid = 0;
    if (grid == 0) {
        if (n_in != 21 || out_size != T * DM || ws_size < WS_END) { fprintf(stderr, "kernel_launch: unexpected shapes (n_in %d out %d ws %zu, need %zu)\n", n_in, out_size, ws_size, (size_t)WS_END); grid = -1; return; }
        int dev = 0, cus = 0, per_cu = 0;
        (void)hipGetDevice(&dev);
        (void)hipDeviceGetAttribute(&cus, hipDeviceAttributeMultiprocessorCount, dev);
        (void)hipFuncSetAttribute((const void*)fwd, hipFuncAttributeMaxDynamicSharedMemorySize, LDS_BYTES);
        (void)hipOccupancyMaxActiveBlocksPerMultiprocessor(&per_cu, (const void*)fwd, 512, LDS_BYTES);
        if (per_cu < 1) per_cu = 1;
        grid = cus * per_cu;
    }
    if (grid < 0) return;
    Params p{};
    for (int i = 0; i < 21; ++i) p.in[i] = (const float*)d_in[i];
    p.out = (float*)d_out; p.ws = (unsigned char*)d_ws;
#if N_LAUNCHES == 1
    (void)hipMemsetAsync((char*)d_ws + WS_BAR, 0, 16384, stream);
    p.ph_lo = 0; p.ph_hi = 18;
    void* args[] = {&p};
    hipError_t e = hipLaunchCooperativeKernel((const void*)fwd, dim3(grid), dim3(512), args, LDS_BYTES, stream);
    if (e != hipSuccess) fprintf(stderr, "cooperative launch failed: %s (grid %d)\n", hipGetErrorString(e), grid);
#else
    for (int k = 0; k < 18; ++k) { p.ph_lo = k; p.ph_hi = k + 1; hipLaunchKernelGGL(fwd, dim3(grid), dim3(512), LDS_BYTES, stream, p); }
#endif
}
```
